# Optimizing an MI355X kernel written in HIP

```python
import math
import jax, jax.numpy as jnp
from jax import lax
import numpy as np

D_MODEL = 2048
BATCH = 2
SEQ = 4096
DEPTH = 1

HEAD_DIM = 128
N_HEADS = D_MODEL // HEAD_DIM
H_A = N_HEADS // 2
H_B = N_HEADS - H_A
D_A = H_A * HEAD_DIM
D_B = H_B * HEAD_DIM
D_PROJ = 3 * D_A + 3 * D_B + H_B
DILATED_PATTERNS = ((128, 1), (512, 4), (2048, 16))
NUM_BUCKETS = 32
MAX_DISTANCE = 2048
FOX_BLOCK = 128
D_FF = ((8 * D_MODEL // 3 + 127) // 128) * 128
RMS_EPS = 1e-6
NEG_INF = -1e30
ATTN_SCALE = HEAD_DIM ** -0.5

kernel_name = "hybrid_dilated_fox_macaron"


def rmsnorm(x, g):
    xf = x.astype(jnp.float32)
    y = xf * lax.rsqrt(jnp.mean(xf * xf, axis=-1, keepdims=True) + RMS_EPS)
    return (y * g.astype(jnp.float32)).astype(x.dtype)


def swiglu_ffn(x, w_in, w_out):
    gate, up = jnp.split(x @ w_in, 2, axis=-1)
    return (jax.nn.silu(gate) * up) @ w_out


def t5_causal_bucket(dist):
    max_exact = NUM_BUCKETS // 2
    d = dist.astype(jnp.float32)
    large = max_exact + (jnp.log(jnp.maximum(d, 1.0) / max_exact)
                         / math.log(MAX_DISTANCE / max_exact)
                         * (NUM_BUCKETS - max_exact)).astype(jnp.int32)
    large = jnp.minimum(large, NUM_BUCKETS - 1)
    return jnp.where(dist < max_exact, dist, large)


def dilated_window_partial(q, k, v, rel_table, window, dilation):
    B, S, H, D = q.shape
    m = window // dilation
    L = m
    span = dilation * L
    Sp = -(-S // span) * span
    n = Sp // dilation
    nb = n // L

    def to_sub(t):
        t = jnp.pad(t, ((0, 0), (0, Sp - S), (0, 0), (0, 0)))
        t = t.reshape(B, n, dilation, H, D).transpose(0, 2, 3, 1, 4)
        return t.reshape(B, dilation, H, nb, L, D)

    def with_prev(t):
        prev = jnp.pad(t, ((0, 0), (0, 0), (0, 0), (1, 0), (0, 0), (0, 0)))[:, :, :, :-1]
        return jnp.concatenate([prev, t], axis=4)

    qs = to_sub(q)
    kw = with_prev(to_sub(k))
    vw = with_prev(to_sub(v))

    iq = jnp.arange(L)[:, None] + L
    ik = jnp.arange(2 * L)[None, :]
    delta = iq - ik
    band = (delta >= 0) & (delta <= m)
    bucket = t5_causal_bucket(jnp.clip(delta, 0, None) * dilation)
    bias = rel_table[bucket].astype(jnp.float32).transpose(2, 0, 1)
    blk = jnp.arange(nb)
    key_ok = (blk[:, None] * L + ik - L) >= 0
    mask = band[None] & key_ok[:, None, :]

    logits = jnp.einsum('bzhnqd,bzhnkd->bzhnqk', qs, kw) * ATTN_SCALE + bias[:, None]
    logits = jnp.where(mask, logits, NEG_INF)
    mx = jnp.max(logits, axis=-1)
    p = jnp.exp(logits - mx[..., None])
    den = jnp.sum(p, axis=-1)
    num = jnp.einsum('bzhnqk,bzhnkd->bzhnqd', p, vw)

    def from_sub(t):
        rest = t.shape[5:]
        t = t.reshape((B, dilation, H, n) + rest)
        t = jnp.moveaxis(t, 3, 1)
        return t.reshape((B, Sp, H) + rest)[:, :S]

    return from_sub(num), from_sub(den), from_sub(mx)


def dilated_attention(q, k, v, rel_table):
    parts = [dilated_window_partial(q, k, v, rel_table, w, d) for (w, d) in DILATED_PATTERNS]
    mx = jnp.max(jnp.stack([pt[2] for pt in parts], axis=0), axis=0)
    num = None
    den = None
    for pnum, pden, pmx in parts:
        scale = jnp.exp(pmx - mx)
        num = pnum * scale[..., None] if num is None else num + pnum * scale[..., None]
        den = pden * scale if den is None else den + pden * scale
    return num / den[..., None]


def forgetting_attention(q, k, v, log_f):
    B, S, H, D = q.shape
    c = jnp.cumsum(log_f, axis=1)
    c_k = c.transpose(0, 2, 1)
    nblk = S // FOX_BLOCK
    q_blocks = q.reshape(B, nblk, FOX_BLOCK, H, D).transpose(1, 0, 3, 2, 4)
    c_blocks = c.reshape(B, nblk, FOX_BLOCK, H).transpose(1, 0, 3, 2)
    kpos = jnp.arange(S)

    def block(args):
        q_blk, c_blk, i = args
        qpos = i * FOX_BLOCK + jnp.arange(FOX_BLOCK)
        logits = (jnp.einsum('bhqd,bkhd->bhqk', q_blk, k) * ATTN_SCALE
                  + c_blk[..., None] - c_k[:, :, None, :])
        logits = jnp.where(kpos[None, :] <= qpos[:, None], logits, NEG_INF)
        p = jax.nn.softmax(logits, axis=-1)
        return jnp.einsum('bhqk,bkhd->bhqd', p, v)

    out = lax.map(block, (q_blocks, c_blocks, jnp.arange(nblk)))
    return out.transpose(1, 0, 3, 2, 4).reshape(B, S, H, D)


def setup_inputs(seed: int = 0) -> dict:
    key = jax.random.key(seed)
    ks = jax.random.split(key, 17)
    f32 = jnp.float32

    def gain(k, shape):
        return (1.0 + 0.02 * jax.random.normal(k, shape)).astype(f32)

    x = jax.random.normal(ks[0], (BATCH, SEQ, D_MODEL), f32)
    ffn1_norm = gain(ks[1], (DEPTH, D_MODEL))
    ffn1_w_in = jax.random.normal(ks[2], (DEPTH, D_MODEL, 2 * D_FF), f32) * D_MODEL ** -0.5
    ffn1_w_out = jax.random.normal(ks[3], (DEPTH, D_FF, D_MODEL), f32) * D_FF ** -0.5
    mix_norm = gain(ks[4], (DEPTH, D_MODEL))
    w_in = jax.random.normal(ks[5], (DEPTH, D_MODEL, D_PROJ), f32) * D_MODEL ** -0.5
    q_norm_a = gain(ks[6], (DEPTH, HEAD_DIM))
    k_norm_a = gain(ks[7], (DEPTH, HEAD_DIM))
    q_norm_b = gain(ks[8], (DEPTH, HEAD_DIM))
    k_norm_b = gain(ks[9], (DEPTH, HEAD_DIM))
    forget_bias = (jnp.linspace(1.0, 4.0, H_B, dtype=f32)[None, :]
                   + 0.1 * jax.random.normal(ks[10], (DEPTH, H_B), f32))
    rel_bias_table = 0.5 * jax.random.normal(ks[11], (NUM_BUCKETS, H_A), f32)
    w_out = jax.random.normal(ks[12], (DEPTH, D_A + D_B, D_MODEL), f32) * (D_A + D_B) ** -0.5
    ffn2_norm = gain(ks[13], (DEPTH, D_MODEL))
    ffn2_w_in = jax.random.normal(ks[14], (DEPTH, D_MODEL, 2 * D_FF), f32) * D_MODEL ** -0.5
    ffn2_w_out = jax.random.normal(ks[15], (DEPTH, D_FF, D_MODEL), f32) * D_FF ** -0.5
    return {"x": x, "ffn1_norm": ffn1_norm, "ffn1_w_in": ffn1_w_in, "ffn1_w_out": ffn1_w_out,
            "mix_norm": mix_norm, "w_in": w_in, "q_norm_a": q_norm_a, "k_norm_a": k_norm_a,
            "q_norm_b": q_norm_b, "k_norm_b": k_norm_b, "forget_bias": forget_bias,
            "rel_bias_table": rel_bias_table, "w_out": w_out, "ffn2_norm": ffn2_norm,
            "ffn2_w_in": ffn2_w_in, "ffn2_w_out": ffn2_w_out}


def reference(x, ffn1_norm, ffn1_w_in, ffn1_w_out, mix_norm, w_in, q_norm_a, k_norm_a,
              q_norm_b, k_norm_b, forget_bias, rel_bias_table, w_out, ffn2_norm,
              ffn2_w_in, ffn2_w_out):
    B, S, _ = x.shape
    splits = np.cumsum([D_A, D_A, D_A, D_B, D_B, D_B]).tolist()
    for l in range(DEPTH):
        x = x + 0.5 * swiglu_ffn(rmsnorm(x, ffn1_norm[l]), ffn1_w_in[l], ffn1_w_out[l])

        h = rmsnorm(x, mix_norm[l])
        proj = h @ w_in[l]
        qa, ka, va, qb, kb, vb, f_pre = jnp.split(proj, splits, axis=-1)

        def heads(t, n_h):
            return t.reshape(B, S, n_h, HEAD_DIM).astype(jnp.float32)

        qa = rmsnorm(heads(qa, H_A), q_norm_a[l])
        ka = rmsnorm(heads(ka, H_A), k_norm_a[l])
        va = heads(va, H_A)
        qb = rmsnorm(heads(qb, H_B), q_norm_b[l])
        kb = rmsnorm(heads(kb, H_B), k_norm_b[l])
        vb = heads(vb, H_B)
        log_f = jax.nn.log_sigmoid(f_pre.astype(jnp.float32) + forget_bias[l].astype(jnp.float32))

        out_a = dilated_attention(qa, ka, va, rel_bias_table)
        out_b = forgetting_attention(qb, kb, vb, log_f)
        mixed = jnp.concatenate([out_a.reshape(B, S, D_A), out_b.reshape(B, S, D_B)],
                                axis=-1).astype(x.dtype)
        x = x + mixed @ w_out[l]

        x = x + 0.5 * swiglu_ffn(rmsnorm(x, ffn2_norm[l]), ffn2_w_in[l], ffn2_w_out[l])
    return x
```

```cpp
#include <hip/hip_runtime.h>
#include <hip/hip_cooperative_groups.h>
#include <cstdio>
#include <cstdint>
namespace cg = cooperative_groups;

#ifndef MK_MULTI
#define MK_MULTI 0
#endif

namespace pg8 {
#define PG8_LAS __attribute__((address_space(3)))
typedef unsigned short bf16_t;
typedef short bf16x8 __attribute__((ext_vector_type(8)));
typedef float f32x4 __attribute__((ext_vector_type(4)));
typedef unsigned u32x4 __attribute__((ext_vector_type(4)));
constexpr int BM = 256, BK = 64, HALF = 128, HTB = HALF * BK * 2  , STAGE_BYTES = 8 * HTB, NXCD = 8, WGM = 8;

__host__ __device__ __forceinline__ int lds_byte(int r, int c) { const int st = (r >> 4) * 2 + (c >> 5), rr = r & 15, cc = c & 31, ob = rr * 64 + cc * 2; return st * 1024 + (ob ^ (((ob >> 9) & 1) << 5)); }
__host__ __device__ __forceinline__ void stage_rc(int b, int& R, int& C) { const int st = b / 1024, sb = b % 1024, swz = sb ^ (((sb >> 9) & 1) << 5); R = (st >> 1) * 16 + swz / 64; C = (st & 1) * 32 + (swz % 64) / 2; }
__host__ __device__ __forceinline__ int perm32(int rho) { const int n = rho >> 4, i = rho & 15; return 8 * (i >> 2) + 4 * n + (i & 3); }

struct Unit { int pm, pn; };
struct Gemm { const bf16_t* A; const bf16_t* Bt; int M, N, K; };

struct StaticOrder {
    int nM, nN, nwg, G, c;
    __host__ __device__ void init(int M, int N, int G_, int c_) { nM = M / BM; nN = N / BM; nwg = nM * nN; G = G_; c = c_; }
    __host__ __device__ bool next(int i, Unit& u) const {
        const long L = (long)i * G + c; if (L >= nwg) return false;
        int wgid = (int)L; { const int q = nwg / NXCD, r = nwg % NXCD, xcd = wgid % NXCD, off = wgid / NXCD; wgid = (xcd < r ? xcd * (q + 1) : r * (q + 1) + (xcd - r) * q) + off; }
        const int nig = WGM * nN, gid = wgid / nig, fm = gid * WGM, gsz = (nM - fm) < WGM ? (nM - fm) : WGM;
        u.pm = fm + ((wgid % nig) % gsz); u.pn = (wgid % nig) / gsz; return true;
    }
    __device__ __forceinline__ void a_ready(const Unit&) const {}
    __device__ __forceinline__ void done(const Unit&) const {}
};

__device__ __forceinline__ unsigned cvt_pk_bf16(float lo, float hi) { unsigned r; asm volatile("v_cvt_pk_bf16_f32 %0, %1, %2" : "=v"(r) : "v"(lo), "v"(hi)); return r; }


typedef float f32x2 __attribute__((ext_vector_type(2)));

struct EpiSwiglu {
    static constexpr bool PERM = true, AFTER_DRAIN = false;
    bf16_t* O; int ldc;
    __device__ __forceinline__ void operator()(const f32x4 (&acc)[2][2][4][2], const Unit& u, int wr, int wc, int fr, int fq) const {
        const int row0 = u.pm * BM + wr * 64 + fr, col0 = u.pn * HALF + wc * 32 + 8 * fq;
#pragma unroll
        for (int ai = 0; ai < 2; ++ai)
#pragma unroll
            for (int m = 0; m < 4; ++m) {
                bf16_t* rowp = O + (size_t)(row0 + ai * HALF + m * 16) * ldc + col0;
                float r[8];
#pragma unroll
                for (int n = 0; n < 2; ++n)
#pragma unroll
                    for (int j = 0; j < 4; ++j) {
                        const float g = acc[ai][0][m][n][j], up = acc[ai][1][m][n][j];
                        const float e = __builtin_amdgcn_exp2f(-1.4426950408889634f * g);
                        r[n * 4 + j] = g * __builtin_amdgcn_rcpf(1.0f + e) * up;
                    }
                u32x4 w; w.x = cvt_pk_bf16(r[0], r[1]); w.y = cvt_pk_bf16(r[2], r[3]); w.z = cvt_pk_bf16(r[4], r[5]); w.w = cvt_pk_bf16(r[6], r[7]);
                *(u32x4*)rowp = w;
            }
    }
};
struct EpiRes {
    static constexpr bool PERM = false, AFTER_DRAIN = false;
    const float* base; float* out; int ldc; float scale;
    __device__ __forceinline__ void operator()(const f32x4 (&acc)[2][2][4][2], const Unit& u, int wr, int wc, int fr, int fq) const {
        const int row0 = u.pm * BM + wr * 64 + fr, col0 = u.pn * BM + wc * 32 + 4 * fq;
#pragma unroll
        for (int ai = 0; ai < 2; ++ai)
#pragma unroll
            for (int m = 0; m < 4; ++m) {
                const size_t off = (size_t)(row0 + ai * HALF + m * 16) * ldc + col0;
                f32x4 b[2][2];
#pragma unroll
                for (int bj = 0; bj < 2; ++bj)
#pragma unroll
                    for (int n = 0; n < 2; ++n) b[bj][n] = *(const f32x4*)(base + off + bj * HALF + n * 16);
#pragma unroll
                for (int bj = 0; bj < 2; ++bj)
#pragma unroll
                    for (int n = 0; n < 2; ++n) *(f32x4*)(out + off + bj * HALF + n * 16) = b[bj][n] + acc[ai][bj][m][n] * scale;
                asm volatile("" ::: "memory");
            }
    }
};
struct EpiQKV {
    static constexpr bool PERM = true, AFTER_DRAIN = false;
    bf16_t* O; int ldc; const float* gains;
    PG8_LAS float* xch;
    __device__ __forceinline__ void operator()(const f32x4 (&acc)[2][2][4][2], const Unit& u, int wr, int wc, int fr, int fq) const {
        const int seg = u.pn >> 2;
        const bool norm = (seg != 2) && (seg != 5);
        const int row0 = u.pm * BM + wr * 64 + fr, col0 = u.pn * BM + wc * 32 + 8 * fq;
        if (norm) {
#pragma unroll
            for (int ai = 0; ai < 2; ++ai)
#pragma unroll
                for (int m = 0; m < 4; ++m)
#pragma unroll
                    for (int bj = 0; bj < 2; ++bj) {
                        const f32x4 a = acc[ai][bj][m][0], b = acc[ai][bj][m][1];
                        float s = (a[0] * a[0] + a[1] * a[1]) + (a[2] * a[2] + a[3] * a[3]) + (b[0] * b[0] + b[1] * b[1]) + (b[2] * b[2] + b[3] * b[3]);
                        s += __shfl_xor(s, 16); s += __shfl_xor(s, 32);
                        if (fq == 0) xch[((ai * HALF + wr * 64 + m * 16 + fr) * 2 + bj) * 4 + wc] = s;
                    }
            asm volatile("s_waitcnt lgkmcnt(0)" ::: "memory"); __builtin_amdgcn_s_barrier(); asm volatile("" ::: "memory");
            const int gi = (seg == 0) ? 0 : (seg == 1) ? 1 : (seg == 3) ? 2 : 3;
            const float* gp = gains + gi * 128 + wc * 32 + 8 * fq;
            const f32x4 g0 = *(const f32x4*)gp, g1 = *(const f32x4*)(gp + 4);
#pragma unroll
            for (int ai = 0; ai < 2; ++ai)
#pragma unroll
                for (int m = 0; m < 4; ++m) {
                    bf16_t* rowp = O + (size_t)(row0 + ai * HALF + m * 16) * ldc + col0;
#pragma unroll
                    for (int bj = 0; bj < 2; ++bj) {
                        const f32x4 p = *(const PG8_LAS f32x4*)(xch + ((ai * HALF + wr * 64 + m * 16 + fr) * 2 + bj) * 4);
                        const float rs = __builtin_amdgcn_rsqf(((p[0] + p[1]) + (p[2] + p[3])) * (1.0f / 128.0f) + 1e-6f);
                        const f32x4 v0 = acc[ai][bj][m][0] * g0 * rs, v1 = acc[ai][bj][m][1] * g1 * rs;
                        u32x4 w; w.x = cvt_pk_bf16(v0[0], v0[1]); w.y = cvt_pk_bf16(v0[2], v0[3]); w.z = cvt_pk_bf16(v1[0], v1[1]); w.w = cvt_pk_bf16(v1[2], v1[3]);
                        *(u32x4*)(rowp + bj * HALF) = w;
                    }
                    asm volatile("" ::: "memory");
                }
        } else {
#pragma unroll
            for (int ai = 0; ai < 2; ++ai)
#pragma unroll
                for (int m = 0; m < 4; ++m) {
                    bf16_t* rowp = O + (size_t)(row0 + ai * HALF + m * 16) * ldc + col0;
#pragma unroll
                    for (int bj = 0; bj < 2; ++bj) {
                        const f32x4 v0 = acc[ai][bj][m][0], v1 = acc[ai][bj][m][1];
                        u32x4 w; w.x = cvt_pk_bf16(v0[0], v0[1]); w.y = cvt_pk_bf16(v0[2], v0[3]); w.z = cvt_pk_bf16(v1[0], v1[1]); w.w = cvt_pk_bf16(v1[2], v1[3]);
                        *(u32x4*)(rowp + bj * HALF) = w;
                    }
                }
        }
    }
};

template <class Epi, class Sched, bool ALIGN_EPI = false, bool SP2 = false>
__device__ __forceinline__ void gemm_phase(PG8_LAS unsigned char* lds, const Gemm g, const Sched& S, const Epi& E) {
    const int tid = threadIdx.x, wid = __builtin_amdgcn_readfirstlane(tid >> 6), lane = tid & 63, wr = wid >> 2, wc = wid & 3, fr = lane & 15, fq = lane >> 4;
    const int K = g.K, nt = K / BK;
    unsigned voffA[2], voffB[2];
#pragma unroll
    for (int i = 0; i < 2; ++i) { int R, C; stage_rc(tid * 16 + i * 8192, R, C); const int Rb = Epi::PERM ? ((R & ~31) + perm32(R & 31)) : R;
        voffA[i] = (unsigned)(R * K + C) * 2u; voffB[i] = (unsigned)(Rb * K + C) * 2u; }
    const size_t kstep = (size_t)(BK * 2);
    const size_t hstep = (size_t)HALF * K * 2;
    const size_t tstep = 2 * hstep;
    const unsigned ldsw = (unsigned)wid * 1024u;
    const int aoff = lds_byte(wr * 64 + fr, fq * 8), boff = lds_byte(wc * 32 + fr, fq * 8);
#define PG8_SA(b, h) (((b) * 2 + (h)) * HTB)
#define PG8_SB(b, h) ((4 + (b) * 2 + (h)) * HTB)
#define PG8_STAGE(bufoff, gbase, voff) do { _Pragma("unroll") for (int _i = 0; _i < 2; ++_i) \
        __builtin_amdgcn_global_load_lds((const unsigned*)((const char*)(gbase) + (voff)[_i]), (PG8_LAS unsigned*)(lds + (bufoff) + ldsw + _i * 8192), 16, 0, 0); } while (0)
#define PG8_LDA(dst, b, h) do { _Pragma("unroll") for (int m = 0; m < 4; ++m) _Pragma("unroll") for (int k = 0; k < 2; ++k) dst[m][k] = *(const PG8_LAS bf16x8*)(lds + PG8_SA(b, h) + aoff + m * 2048 + k * 1024); } while (0)
#define PG8_LDB(dst, b, h) do { _Pragma("unroll") for (int n = 0; n < 2; ++n) _Pragma("unroll") for (int k = 0; k < 2; ++k) dst[n][k] = *(const PG8_LAS bf16x8*)(lds + PG8_SB(b, h) + boff + n * 2048 + k * 1024); } while (0)
#define PG8_MMA(ai, bj, At, Bt) do { __builtin_amdgcn_s_setprio(1); _Pragma("unroll") for (int m = 0; m < 4; ++m) _Pragma("unroll") for (int n = 0; n < 2; ++n) _Pragma("unroll") for (int k = 0; k < 2; ++k) \
        acc[ai][bj][m][n] = __builtin_amdgcn_mfma_f32_16x16x32_bf16(Bt[n][k], At[m][k], acc[ai][bj][m][n], 0, 0, 0); __builtin_amdgcn_s_setprio(0); } while (0)
#define PG8_WAIT_V(n) asm volatile("s_waitcnt vmcnt(" #n ")" ::: "memory")
#define PG8_WAIT_L(n) asm volatile("s_waitcnt lgkmcnt(" #n ")" ::: "memory")
#define PG8_BAR __builtin_amdgcn_s_barrier()
#define PG8_SCHED __builtin_amdgcn_sched_barrier(0)
    Unit cur, nxt; int ui = 0;
    if (!S.next(0, cur)) return;
    f32x4 acc[2][2][4][2];
#pragma unroll
    for (int a = 0; a < 2; ++a)
#pragma unroll
        for (int b = 0; b < 2; ++b)
#pragma unroll
            for (int m = 0; m < 4; ++m)
#pragma unroll
                for (int n = 0; n < 2; ++n) acc[a][b][m][n] = (f32x4){0.f, 0.f, 0.f, 0.f};
    bf16x8 At[4][2], B0[2][2], B1[2][2];
    const char* cA = (const char*)g.A + (size_t)cur.pm * tstep; const char* cB = (const char*)g.Bt + (size_t)cur.pn * tstep;
    S.a_ready(cur);
    if constexpr (SP2) {
        PG8_STAGE(PG8_SB(0, 0), cB, voffB); PG8_STAGE(PG8_SB(0, 1), cB + hstep, voffB); PG8_STAGE(PG8_SA(0, 0), cA, voffA); PG8_STAGE(PG8_SA(0, 1), cA + hstep, voffA);
        if (wr == 1) PG8_BAR;
        PG8_WAIT_V(2); PG8_BAR;
        PG8_STAGE(PG8_SB(1, 0), cB + kstep, voffB); PG8_STAGE(PG8_SA(1, 0), cA + kstep, voffA); PG8_STAGE(PG8_SB(1, 1), cB + hstep + kstep, voffB);
        PG8_WAIT_V(6); PG8_BAR;
    } else {
        PG8_STAGE(PG8_SB(0, 0), cB, voffB); PG8_STAGE(PG8_SA(0, 0), cA, voffA); PG8_STAGE(PG8_SB(0, 1), cB + hstep, voffB); PG8_STAGE(PG8_SA(0, 1), cA + hstep, voffA);
        if (wr == 1) PG8_BAR;
        PG8_WAIT_V(4); PG8_BAR;
        PG8_STAGE(PG8_SB(1, 0), cB + kstep, voffB); PG8_STAGE(PG8_SA(1, 0), cA + kstep, voffA); PG8_STAGE(PG8_SB(1, 1), cB + hstep + kstep, voffB);
        PG8_WAIT_V(6); PG8_BAR;
    }
    for (;;) {
        const bool has_next = S.next(ui + 1, nxt);
        const char* nA = has_next ? (const char*)g.A + (size_t)nxt.pm * tstep : cA; const char* nB = has_next ? (const char*)g.Bt + (size_t)nxt.pn * tstep : cB;
        for (int t = 0; t < nt; t += 2) {
            const bool last = (t == nt - 2);
            const char* a1 = cA + (size_t)(t + 1) * kstep;
            const char* a2 = last ? nA : cA + (size_t)(t + 2) * kstep; const char* b2 = last ? nB : cB + (size_t)(t + 2) * kstep;
            const char* a3 = a2 + kstep; const char* b3 = b2 + kstep;
            if (last && has_next) S.a_ready(nxt);
            if constexpr (SP2) {
            PG8_LDB(B0, 0, 0); PG8_LDB(B1, 0, 1); PG8_SCHED; PG8_LDA(At, 0, 0); PG8_STAGE(PG8_SA(1, 1), a1 + hstep, voffA);
            PG8_WAIT_V(8); PG8_WAIT_L(0); PG8_BAR; PG8_MMA(0, 0, At, B0); PG8_MMA(0, 1, At, B1); PG8_BAR; PG8_SCHED;
            PG8_LDA(At, 0, 1); PG8_STAGE(PG8_SB(0, 0), b2, voffB); PG8_STAGE(PG8_SB(0, 1), b2 + hstep, voffB); PG8_STAGE(PG8_SA(0, 0), a2, voffA);
            PG8_WAIT_V(8); PG8_WAIT_L(0); PG8_BAR; PG8_MMA(1, 0, At, B0); PG8_MMA(1, 1, At, B1); PG8_BAR; PG8_SCHED;
            PG8_LDB(B0, 1, 0); PG8_LDB(B1, 1, 1); PG8_SCHED; PG8_LDA(At, 1, 0); PG8_STAGE(PG8_SA(0, 1), a2 + hstep, voffA);
            PG8_WAIT_V(8); PG8_WAIT_L(0); PG8_BAR; PG8_MMA(0, 0, At, B0); PG8_MMA(0, 1, At, B1); PG8_BAR; PG8_SCHED;
            PG8_LDA(At, 1, 1); PG8_STAGE(PG8_SB(1, 0), b3, voffB); PG8_STAGE(PG8_SB(1, 1), b3 + hstep, voffB); PG8_STAGE(PG8_SA(1, 0), a3, voffA);
            PG8_WAIT_V(8); PG8_WAIT_L(0); PG8_BAR; PG8_MMA(1, 0, At, B0); PG8_MMA(1, 1, At, B1); PG8_BAR; PG8_SCHED;
            } else {
            PG8_LDB(B0, 0, 0); PG8_SCHED; PG8_LDA(At, 0, 0); PG8_STAGE(PG8_SA(1, 1), a1 + hstep, voffA);
            PG8_WAIT_L(8); PG8_BAR; PG8_WAIT_L(0); PG8_MMA(0, 0, At, B0); PG8_BAR; PG8_SCHED;
            PG8_LDB(B1, 0, 1); PG8_STAGE(PG8_SB(0, 0), b2, voffB);
            PG8_BAR; PG8_WAIT_L(0); PG8_MMA(0, 1, At, B1); PG8_BAR;
            PG8_LDA(At, 0, 1); PG8_STAGE(PG8_SA(0, 0), a2, voffA);
            PG8_BAR; PG8_WAIT_L(0); PG8_MMA(1, 0, At, B0); PG8_BAR; PG8_SCHED;
            PG8_STAGE(PG8_SB(0, 1), b2 + hstep, voffB);
            PG8_WAIT_V(6); PG8_BAR; PG8_MMA(1, 1, At, B1); PG8_BAR;
            PG8_LDB(B0, 1, 0); PG8_SCHED; PG8_LDA(At, 1, 0); PG8_STAGE(PG8_SA(0, 1), a2 + hstep, voffA);
            PG8_WAIT_L(8); PG8_BAR; PG8_WAIT_L(0); PG8_MMA(0, 0, At, B0); PG8_BAR; PG8_SCHED;
            PG8_LDB(B1, 1, 1); PG8_STAGE(PG8_SB(1, 0), b3, voffB);
            PG8_BAR; PG8_WAIT_L(0); PG8_MMA(0, 1, At, B1); PG8_BAR;
            PG8_LDA(At, 1, 1); PG8_STAGE(PG8_SA(1, 0), a3, voffA);
            PG8_BAR; PG8_WAIT_L(0); PG8_MMA(1, 0, At, B0); PG8_BAR; PG8_SCHED;
            PG8_STAGE(PG8_SB(1, 1), b3 + hstep, voffB);
            PG8_WAIT_V(6); PG8_BAR; PG8_MMA(1, 1, At, B1); PG8_BAR;
            }
        }
        if constexpr (ALIGN_EPI) { if (wr == 0) PG8_BAR; }
        if constexpr (!Epi::AFTER_DRAIN) { E(acc, cur, wr, wc, fr, fq); S.done(cur); }
        if (!has_next) break;
#pragma unroll
        for (int a = 0; a < 2; ++a)
#pragma unroll
            for (int b = 0; b < 2; ++b)
#pragma unroll
                for (int m = 0; m < 4; ++m)
#pragma unroll
                    for (int n = 0; n < 2; ++n) acc[a][b][m][n] = (f32x4){0.f, 0.f, 0.f, 0.f};
        cur = nxt; cA = nA; cB = nB; ++ui;
        if constexpr (ALIGN_EPI) { if (wr == 1) PG8_BAR; }
    }
    PG8_WAIT_V(0);
    if constexpr (!ALIGN_EPI) { if (wr == 0) PG8_BAR; }
    PG8_BAR;
    if constexpr (Epi::AFTER_DRAIN) { E.fused(acc, cur, wr, wc, fr, fq, lds, wid, lane); S.done(cur); }
#undef PG8_SA
#undef PG8_SB
#undef PG8_STAGE
#undef PG8_LDA
#undef PG8_LDB
#undef PG8_MMA
#undef PG8_WAIT_V
#undef PG8_WAIT_L
#undef PG8_BAR
#undef PG8_SCHED
}

}

namespace att {
typedef unsigned short bf16;
typedef short bf16x8 __attribute__((ext_vector_type(8)));
typedef short s16x4 __attribute__((ext_vector_type(4)));
typedef float f32x16 __attribute__((ext_vector_type(16)));
typedef float f32x4 __attribute__((ext_vector_type(4)));
typedef unsigned u32x4 __attribute__((ext_vector_type(4)));
constexpr float SCALE = 0.08838834764831845f, INV_SCALE = 11.313708498984761f, THR = 8.f;
constexpr float C2 = 1.4426950408889634f * SCALE;
constexpr int NW = 8, QBLK = 32, KVBLK = 64, QB = NW * QBLK, D = 128;
constexpr int SHM_V = KVBLK * D * 2, SHM_K = KVBLK * D * 2;
constexpr int L_V = 0, L_K = 2 * SHM_V, L_WS = L_K + 2 * SHM_K, L_CK = L_WS + NW * 64 * 4, L_TB = L_CK + 2 * 64 * 4, TB_N = 352, TB_PAD = 96, L_END = L_TB + TB_N * 4;

#define KSWZ(row, colB) ((row) * 256 + ((colB) ^ (((row) & 7) << 4)))
#define SBAR() __builtin_amdgcn_sched_barrier(0)
__device__ __forceinline__ int v_st(int k, int c) { const int kk = (k & ~0xC) | ((k & 4) << 1) | ((k & 8) >> 1); return ((kk >> 3) * 4 + (c >> 5)) * 512 + ((kk & 7) * 32 + (c & 31)) * 2; }
__device__ __forceinline__ int v_rd_base(int lane) { return ((lane & 3) << 3) | (((lane >> 2) & 3) << 6) | (((lane >> 4) & 1) << 5) | (((lane >> 5) & 1) << 8); }
constexpr int v_rd_off(int d0, int ks, int half) { return d0 * 512 + ks * 4096 + half * 2048; }
__device__ __forceinline__ int crow(int r, int hi) { return (r & 3) + 8 * (r >> 2) + 4 * hi; }
__device__ __forceinline__ unsigned cvtpk(float lo, float hi) { unsigned r; asm volatile("v_cvt_pk_bf16_f32 %0, %1, %2" : "=v"(r) : "v"(lo), "v"(hi)); return r; }
__device__ __forceinline__ void mask_tile(f32x16& p0, f32x16& p1, int dq, unsigned W) {
    const float NEG = -__builtin_inff();
#pragma unroll
    for (int r = 0; r < 16; ++r) {
        const int c = (r & 3) + 8 * (r >> 2);
        if ((unsigned)(dq - c) >= W) p0[r] = NEG;
        if ((unsigned)(dq - c - 32) >= W) p1[r] = NEG;
    }
}
__device__ __forceinline__ void partialSM(f32x16& p0, f32x16& p1, float& m_reg, float& mn, float& alpha) {
    float pmax = p0[0];
#pragma unroll
    for (int r = 1; r < 16; ++r) pmax = fmaxf(pmax, p0[r]);
#pragma unroll
    for (int r = 0; r < 16; ++r) pmax = fmaxf(pmax, p1[r]);
    { auto rr = __builtin_amdgcn_permlane32_swap(__float_as_uint(pmax), __float_as_uint(pmax), false, false);
      pmax = fmaxf(__uint_as_float(rr[0]), __uint_as_float(rr[1])); }
    if (__builtin_expect(__all((pmax - m_reg) * SCALE <= THR), 1)) { mn = m_reg; alpha = 1.f; }
    else { mn = fmaxf(m_reg, pmax); alpha = __builtin_amdgcn_exp2f((m_reg - mn) * C2); m_reg = mn; }
    const float mnL = -mn * C2;
#pragma unroll
    for (int r = 0; r < 16; ++r) p0[r] = fmaf(p0[r], C2, mnL);
#pragma unroll
    for (int r = 0; r < 16; ++r) p1[r] = fmaf(p1[r], C2, mnL);
#pragma unroll
    for (int r = 0; r < 16; ++r) p0[r] = __builtin_amdgcn_exp2f(p0[r]);
}
__device__ __forceinline__ void finishSM(f32x16& p0, f32x16& p1, float alpha, float& l_reg, bf16x8& pa0, bf16x8& pa1, bf16x8& pa2, bf16x8& pa3) {
#pragma unroll
    for (int r = 0; r < 16; ++r) p1[r] = __builtin_amdgcn_exp2f(p1[r]);
    float ps = 0;
#pragma unroll
    for (int r = 0; r < 16; ++r) ps += p0[r];
#pragma unroll
    for (int r = 0; r < 16; ++r) ps += p1[r];
    { auto rr = __builtin_amdgcn_permlane32_swap(__float_as_uint(ps), __float_as_uint(ps), false, false);
      ps = __uint_as_float(rr[0]) + __uint_as_float(rr[1]); }
    l_reg = l_reg * alpha + ps;
#define PK4(P, B_, OUT) do { unsigned a0 = cvtpk(P[B_+0], P[B_+1]), a1 = cvtpk(P[B_+2], P[B_+3]);                          \
        unsigned b0 = cvtpk(P[B_+4], P[B_+5]), b1 = cvtpk(P[B_+6], P[B_+7]);                                             \
        auto r0 = __builtin_amdgcn_permlane32_swap(a0, b0, false, false); auto r1 = __builtin_amdgcn_permlane32_swap(a1, b1, false, false); \
        u32x4 w = {r0[0], r1[0], r0[1], r1[1]}; OUT = *reinterpret_cast<bf16x8*>(&w); } while (0)
    PK4(p0, 0, pa0); PK4(p0, 8, pa1); PK4(p1, 0, pa2); PK4(p1, 8, pa3);
#undef PK4
}
template <int KB>
__device__ __forceinline__ void qkt(f32x16& p0, f32x16& p1, const char* K_lds, int r32, int hi, const bf16x8* qr) {
    const char* kb[4];
#pragma unroll
    for (int dd = 0; dd < 4; ++dd) kb[dd] = K_lds + KB * SHM_K + KSWZ(r32, (dd * 16 + hi * 8) * 2);
#pragma unroll
    for (int d0 = 0; d0 < 8; ++d0) { const char* a = kb[d0 & 3] + (d0 >> 2) * 128;
        bf16x8 b0 = *reinterpret_cast<const bf16x8*>(a);
        bf16x8 b1 = *reinterpret_cast<const bf16x8*>(a + 32 * 256);
        p0 = __builtin_amdgcn_mfma_f32_32x32x16_bf16(b0, qr[d0], p0, 0, 0, 0);
        p1 = __builtin_amdgcn_mfma_f32_32x32x16_bf16(b1, qr[d0], p1, 0, 0, 0); }
}
template <int VB>
__device__ __forceinline__ void pv_tile(f32x16* o, int vb0, bf16x8 pa0, bf16x8 pa1, bf16x8 pa2, bf16x8 pa3) {
#define TRRD(dst, off) asm volatile("ds_read_b64_tr_b16 %0, %1 offset:%2" : "=&v"(dst) : "v"(vb0), "i"(off) : "memory")
#define PV_D0(d0) do { s16x4 l0, l1, l2, l3, h0, h1, h2, h3; constexpr int b_ = VB * SHM_V + v_rd_off(d0, 0, 0); \
        TRRD(l0, b_); TRRD(h0, b_ + 2048); TRRD(l1, b_ + 4096); TRRD(h1, b_ + 6144); TRRD(l2, b_ + 8192); TRRD(h2, b_ + 10240); TRRD(l3, b_ + 12288); TRRD(h3, b_ + 14336); \
        asm volatile("s_waitcnt lgkmcnt(0)" ::: "memory"); SBAR();   \
        o[d0] = __builtin_amdgcn_mfma_f32_32x32x16_bf16(pa0, (bf16x8){l0[0], l0[1], l0[2], l0[3], h0[0], h0[1], h0[2], h0[3]}, o[d0], 0, 0, 0);   \
        o[d0] = __builtin_amdgcn_mfma_f32_32x32x16_bf16(pa1, (bf16x8){l1[0], l1[1], l1[2], l1[3], h1[0], h1[1], h1[2], h1[3]}, o[d0], 0, 0, 0);   \
        o[d0] = __builtin_amdgcn_mfma_f32_32x32x16_bf16(pa2, (bf16x8){l2[0], l2[1], l2[2], l2[3], h2[0], h2[1], h2[2], h2[3]}, o[d0], 0, 0, 0);   \
        o[d0] = __builtin_amdgcn_mfma_f32_32x32x16_bf16(pa3, (bf16x8){l3[0], l3[1], l3[2], l3[3], h3[0], h3[1], h3[2], h3[3]}, o[d0], 0, 0, 0); } while (0)
    PV_D0(0); PV_D0(1); PV_D0(2); PV_D0(3);
#undef PV_D0
#undef TRRD
}

struct UnitD {
    const bf16* Q; const bf16* K; const bf16* V; size_t pitch;
    bf16* O; size_t opitch;
    float* den; float* mx; size_t spitch;
    const float* c;
    const float* rel; int head; int dil;
    int q0, jlo, jhi; int W;
};

__device__ __forceinline__ void attn_unit(const UnitD& U, char* lds) {
    const int tid = threadIdx.x, wid = __builtin_amdgcn_readfirstlane(tid >> 6), lane = tid & 63, r32 = lane & 31, hi = lane >> 5;
    const bool fox = (U.c != nullptr);
    const int NT = U.jhi - U.jlo;
    const int qlo = U.q0 + wid * QBLK, qm = qlo + r32 - 4 * hi;
    const int W = U.W;
    char* V_lds = lds + L_V; char* K_lds = lds + L_K;
    float* wsl = (float*)(lds + L_WS) + wid * 64; float* li_l = wsl, * al_l = wsl + 32;
    float* ckl = (float*)(lds + L_CK); float* Tl = (float*)(lds + L_TB);
    const int sr = tid >> 4, sc = (tid & 15) * 8, vst0 = v_st(sr, sc), vst1 = v_st(32 + sr, sc), kws = KSWZ(sr, sc * 2);
    const int vb0 = (int)(uintptr_t)V_lds + v_rd_base(lane);
    bf16x8 qr[8];
    { const bf16* qp = U.Q + (size_t)(qlo + r32) * U.pitch + hi * 8;
#pragma unroll
      for (int d0 = 0; d0 < 8; ++d0) qr[d0] = *(const bf16x8*)(qp + d0 * 16); }
    float cqs = 0.f;
    if (fox) cqs = U.c[qlo + r32] * INV_SCALE;
    else {
        for (int i = tid; i < TB_N; i += 512) {
            const int delta = i - TB_PAD; float v = 0.f;
            if (delta >= 0 && delta <= 128) {
                const int dist = delta * U.dil; int bucket;
                if (dist < 16) bucket = dist;
                else { const float dd = (float)dist; int lg = 16 + (int)(logf(dd / 16.0f) / 4.852030263919617f * 16.0f); bucket = lg < 31 ? lg : 31; }
                v = U.rel[bucket * 8 + U.head] * INV_SCALE;
            }
            Tl[i] = v;
        }
    }
    bf16x8 st_k0, st_k1, st_v0, st_v1; float st_c = 0.f;
#define ROWP(p, k0, rr) ((p) + (size_t)((k0) + (rr)) * U.pitch + sc)
#define SLOAD(k0) do { st_v0 = *(const bf16x8*)ROWP(U.V, k0, sr); st_v1 = *(const bf16x8*)ROWP(U.V, k0, 32 + sr); \
                       st_k0 = *(const bf16x8*)ROWP(U.K, k0, sr); st_k1 = *(const bf16x8*)ROWP(U.K, k0, 32 + sr); \
                       if (fox && tid < 64) st_c = -U.c[(k0) + tid] * INV_SCALE; } while (0)
#define SWRITE(bf) do { *(bf16x8*)(K_lds + (bf) * SHM_K + kws) = st_k0; *(bf16x8*)(K_lds + (bf) * SHM_K + kws + 32 * 256) = st_k1; \
                        *(bf16x8*)(V_lds + (bf) * SHM_V + vst0) = st_v0; *(bf16x8*)(V_lds + (bf) * SHM_V + vst1) = st_v1; \
                        if (fox && tid < 64) ckl[(bf) * 64 + tid] = st_c; } while (0)
    float m_reg = -1e30f, l_reg = 0.f; f32x16 o[4];
#pragma unroll
    for (int d = 0; d < 4; ++d)
#pragma unroll
        for (int r = 0; r < 16; ++r) o[d][r] = 0.f;
    SLOAD((U.jhi - 1) * KVBLK); SWRITE(0);
    __syncthreads();
#define STEP(it_, BUF) do { const int kb_ = (U.jhi - 1 - (it_)) * KVBLK; const bool more_ = (it_) + 1 < NT;                                   \
        if (more_) SLOAD(kb_ - KVBLK);                                                                                                     \
        if (kb_ <= qlo + QBLK - 1 && kb_ + KVBLK - 1 >= qlo - W + 1) {                                                                      \
            f32x16 p0, p1; float mn, alpha; bf16x8 pa0, pa1, pa2, pa3;                                                                     \
            if (fox) { const float* ck_ = ckl + (BUF) * 64 + 4 * hi;                                                                        \
                _Pragma("unroll") for (int g = 0; g < 4; ++g) { const f32x4 a_ = *(const f32x4*)(ck_ + 8 * g), b_ = *(const f32x4*)(ck_ + 32 + 8 * g);   \
                    _Pragma("unroll") for (int e = 0; e < 4; ++e) { p0[4 * g + e] = cqs + a_[e]; p1[4 * g + e] = cqs + b_[e]; } } }          \
            else { const float* tb_ = Tl + (TB_PAD - 59) + (qm - kb_);                                                                     \
                _Pragma("unroll") for (int r = 0; r < 16; ++r) { const int c_ = (r & 3) + 8 * (r >> 2); p0[r] = tb_[59 - c_]; p1[r] = tb_[27 - c_]; } }  \
            qkt<BUF>(p0, p1, K_lds, r32, hi, qr);                                                                                           \
            if (kb_ + KVBLK - 1 > qlo || kb_ <= qlo + QBLK - 1 - W) mask_tile(p0, p1, qm - kb_, (unsigned)W);                              \
            partialSM(p0, p1, m_reg, mn, alpha);                                                                                            \
            if (__any(alpha < 1.f)) { if (hi == 0) al_l[r32] = alpha; asm volatile("s_waitcnt lgkmcnt(0)" ::: "memory");                     \
                _Pragma("unroll") for (int d_ = 0; d_ < 4; ++d_) _Pragma("unroll") for (int r = 0; r < 16; ++r) o[d_][r] *= al_l[crow(r, hi)]; }   \
            finishSM(p0, p1, alpha, l_reg, pa0, pa1, pa2, pa3); SBAR();                                                                      \
            pv_tile<BUF>(o, vb0, pa0, pa1, pa2, pa3);                                                                                       \
        }                                                                                                                                   \
        if (more_) { SWRITE((BUF) ^ 1); }                                                                                                   \
        __syncthreads(); } while (0)
    int it = 0;
    for (; it + 1 < NT; it += 2) { STEP(it, 0); STEP(it + 1, 1); }
    if (it < NT) STEP(it, 0);
#undef STEP
#undef SLOAD
#undef SWRITE
#undef ROWP
    if (hi == 0) li_l[r32] = l_reg;
    asm volatile("s_waitcnt lgkmcnt(0)" ::: "memory");
    float rli[16];
#pragma unroll
    for (int r = 0; r < 16; ++r) rli[r] = __builtin_amdgcn_rcpf(li_l[crow(r, hi)]);
    bf16* Ow = U.O + (size_t)qlo * U.opitch;
#pragma unroll
    for (int r = 0; r < 16; ++r) { const int orow = crow(r, hi);
#pragma unroll
        for (int d0 = 0; d0 < 4; ++d0) { const float v = o[d0][r] * rli[r];
            const float vn = __shfl_xor(v, 1);
            if ((r32 & 1) == 0) *(unsigned*)(Ow + (size_t)orow * U.opitch + d0 * 32 + r32) = cvtpk(v, vn); } }
    if (U.den != nullptr && hi == 0) { U.den[(size_t)(qlo + r32) * U.spitch] = l_reg; U.mx[(size_t)(qlo + r32) * U.spitch] = m_reg; }
    __syncthreads();
}
}

constexpr int BATCH = 2, SEQ = 4096, DM = 2048, MROWS = BATCH * SEQ, DFF = 5504, HD = 128, HA = 8, HB = 8, DPROJ = 6152, NQKV = 6144;
constexpr float RMS_EPS = 1e-6f;
constexpr int NWAVES = 8, NTHREADS = 512;
constexpr int LDS_BYTES = 147456;
constexpr int RING_BYTES = 131072, XCH_OFF = RING_BYTES, MISC_OFF = XCH_OFF + 8192;
typedef unsigned short bf16;
typedef float f32x4 __attribute__((ext_vector_type(4)));
typedef unsigned u32x4v __attribute__((ext_vector_type(4)));
typedef unsigned u32x2v __attribute__((ext_vector_type(2)));
#define LAS __attribute__((address_space(3)))

constexpr size_t MiB = 1u << 20;
constexpr size_t WS_CTL = 0;
constexpr size_t WS_WF = 64 * 1024;
constexpr size_t WS_LOGF = 128 * 1024;
constexpr size_t WS_CUM = 384 * 1024;
constexpr size_t WS_STAT = 640 * 1024;
constexpr size_t WS_W1I = 4 * MiB;
constexpr size_t WS_W1O = WS_W1I + 43 * MiB;
constexpr size_t WS_WIN = WS_W1O + 22 * MiB;
constexpr size_t WS_WOUT = WS_WIN + 24 * MiB;
constexpr size_t WS_W2I = WS_WOUT + 8 * MiB;
constexpr size_t WS_W2O = WS_W2I + 43 * MiB;
constexpr size_t WS_H = WS_W2O + 22 * MiB;
constexpr size_t WS_ACT = WS_H + 32 * MiB;
constexpr size_t WS_OPART = WS_ACT + 96 * MiB;
constexpr size_t WS_END = WS_OPART + 48 * MiB;

struct Args {
    const float* x; const float* n1; const float* w1i; const float* w1o; const float* nmix; const float* win;
    const float* gains[4]; const float* fbias; const float* rel; const float* wout; const float* n2; const float* w2i; const float* w2o;
    float* out; unsigned char* ws; int ph_lo, ph_hi;
};

__device__ __forceinline__ float wave_sum(float v) {
#pragma unroll
    for (int o = 1; o < 64; o <<= 1) v += __shfl_xor(v, o);
    return v;
}
__device__ __forceinline__ unsigned f2bf(float f) { unsigned u = __builtin_bit_cast(unsigned, f); return (u + 0x7fffu + ((u >> 16) & 1u)) >> 16; }
__device__ __forceinline__ unsigned pk2(float lo, float hi) { return f2bf(lo) | (f2bf(hi) << 16); }

__device__ __forceinline__ void transpose_item(const float* W, int ldw, int K, int k0, int n0, bf16* WT, int drow0, LAS float* scr, int lane) {
#pragma unroll 8
    for (int i = 0; i < 32; ++i) { const int kk = 2 * i + (lane >> 5); scr[kk * 33 + (lane & 31)] = W[(size_t)(k0 + kk) * ldw + n0 + (lane & 31)]; }
    asm volatile("s_waitcnt lgkmcnt(0)" ::: "memory");
    const int c = lane & 7;
#pragma unroll
    for (int j = 0; j < 4; ++j) { const int n = (lane >> 3) + 8 * j; const LAS float* s = scr + (8 * c) * 33 + n;
        u32x4v o; o.x = pk2(s[0 * 33], s[1 * 33]); o.y = pk2(s[2 * 33], s[3 * 33]); o.z = pk2(s[4 * 33], s[5 * 33]); o.w = pk2(s[6 * 33], s[7 * 33]);
        *(u32x4v*)(WT + (size_t)(drow0 + n) * K + k0 + 8 * c) = o; }
    asm volatile("s_waitcnt lgkmcnt(0)" ::: "memory");
}
__device__ __forceinline__ void norm_row(const float* xrow, const float* g, bf16* orow, int lane, const float* wf, const float* fbias, float* logf_row) {
    const f32x4* xr = (const f32x4*)xrow + lane; const f32x4* gr = (const f32x4*)g + lane;
    f32x4 v[8]; float s = 0.f;
#pragma unroll
    for (int j = 0; j < 8; ++j) { v[j] = xr[64 * j]; s += (v[j].x * v[j].x + v[j].y * v[j].y) + (v[j].z * v[j].z + v[j].w * v[j].w); }
    const float rstd = 1.0f / sqrtf(wave_sum(s) * (1.0f / DM) + RMS_EPS);
    unsigned long long* o8 = (unsigned long long*)orow + lane;
#pragma unroll
    for (int j = 0; j < 8; ++j) { v[j] = v[j] * rstd * gr[64 * j];
        o8[64 * j] = (unsigned long long)pk2(v[j].x, v[j].y) | ((unsigned long long)pk2(v[j].z, v[j].w) << 32); }
    if (wf != nullptr) {
        float my = 0.f;
#pragma unroll
        for (int c = 0; c < 8; ++c) { const f32x4* wr = (const f32x4*)(wf + c * DM) + lane; float a = 0.f;
#pragma unroll
            for (int j = 0; j < 8; ++j) { const f32x4 w = wr[64 * j]; a += (v[j].x * w.x + v[j].y * w.y) + (v[j].z * w.z + v[j].w * w.w); }
            a = wave_sum(a); if (lane == c) my = a; }
        if (lane < 8) { const float z = my + fbias[lane]; logf_row[lane] = fminf(z, 0.f) - log1pf(expf(-fabsf(z))); }
    }
}

__global__ void __launch_bounds__(NTHREADS, 2) hybrid_fwd(Args a) {
    extern __shared__ __attribute__((aligned(16))) unsigned char lds[];
    const int tid = threadIdx.x, lane = tid & 63, wave = __builtin_amdgcn_readfirstlane(tid >> 6);
    const int G = gridDim.x, bx = blockIdx.x;
    const int gw = bx * NWAVES + wave, NGW = G * NWAVES;
    unsigned char* ws = a.ws;
    bf16* W1I = (bf16*)(ws + WS_W1I); bf16* W1O = (bf16*)(ws + WS_W1O); bf16* WIN = (bf16*)(ws + WS_WIN); bf16* WOUT = (bf16*)(ws + WS_WOUT);
    bf16* W2I = (bf16*)(ws + WS_W2I); bf16* W2O = (bf16*)(ws + WS_W2O);
    bf16* H = (bf16*)(ws + WS_H); bf16* ACT = (bf16*)(ws + WS_ACT); bf16* OPART = (bf16*)(ws + WS_OPART);
    float* WF = (float*)(ws + WS_WF); float* LOGF = (float*)(ws + WS_LOGF); float* CUM = (float*)(ws + WS_CUM);
    float* DEN = (float*)(ws + WS_STAT); float* MX = DEN + 3 * MROWS * 8;
    unsigned* CTL = (unsigned*)(ws + WS_CTL);
    LAS unsigned char* ldsl = (LAS unsigned char*)lds;
    const int lo = a.ph_lo, hi = a.ph_hi;
#ifdef ONLY_PHASE
#define IN(k) ((k) == ONLY_PHASE)
#else
#define IN(k) (lo <= (k) && (k) < hi)
#endif
#if MK_MULTI
#define GRID_SYNC() do {} while (0)
#else
    cg::grid_group grid = cg::this_grid();
#define GRID_SYNC() grid.sync()
#endif

    if (IN(0)) {
        if (bx == 0 && tid == 0) CTL[0] = 0u;
        if (bx == 1 % G) { const int k = tid >> 7, j = tid & 127; const float* gp = (k == 0) ? a.gains[0] : (k == 1) ? a.gains[1] : (k == 2) ? a.gains[2] : a.gains[3];
            ((float*)(CTL + 256))[tid] = gp[j]; }
        LAS float* scr = (LAS float*)(ldsl + wave * 16384);
        constexpr int I_FI = (DM / 64) * (2 * DFF / 32), I_FO = (DFF / 64) * (DM / 32), I_IN = (DM / 64) * (NQKV / 32), I_OUT = (DM / 64) * (DM / 32);
        constexpr int NITEMS = 2 * I_FI + 2 * I_FO + I_IN + I_OUT;
        for (int it = gw; it < NITEMS; it += NGW) {
            int r = it; const float* W; bf16* WT; int K, ldw, nblk, kind;
            if (r < I_FI) { W = a.w1i; WT = W1I; K = DM; ldw = 2 * DFF; nblk = 2 * DFF / 32; kind = 1; }
            else if ((r -= I_FI) < I_FI) { W = a.w2i; WT = W2I; K = DM; ldw = 2 * DFF; nblk = 2 * DFF / 32; kind = 1; }
            else if ((r -= I_FI) < I_FO) { W = a.w1o; WT = W1O; K = DFF; ldw = DM; nblk = DM / 32; kind = 0; }
            else if ((r -= I_FO) < I_FO) { W = a.w2o; WT = W2O; K = DFF; ldw = DM; nblk = DM / 32; kind = 0; }
            else if ((r -= I_FO) < I_IN) { W = a.win; WT = WIN; K = DM; ldw = DPROJ; nblk = NQKV / 32; kind = 0; }
            else { r -= I_IN; W = a.wout; WT = WOUT; K = DM; ldw = DM; nblk = DM / 32; kind = 0; }
            const int kb = r / nblk, nb = r % nblk, n0 = nb * 32;
            int drow = n0;
            if (kind == 1) { const int half = n0 / DFF, jj = n0 % DFF; drow = (jj / 128) * 256 + half * 128 + (jj % 128); }
            transpose_item(W, ldw, K, kb * 64, n0, WT, drow, scr, lane);
        }
        for (int i = bx * NTHREADS + tid; i < 8 * DM; i += G * NTHREADS) { const int c = i / DM, k = i % DM; WF[i] = a.win[(size_t)k * DPROJ + NQKV + c]; }
        for (int m = gw; m < MROWS; m += NGW) norm_row(a.x + (size_t)m * DM, a.n1, H + (size_t)m * DM, lane, nullptr, nullptr, nullptr);
        if (hi > 1) GRID_SYNC();
    }
    if (IN(1)) {
        pg8::Gemm g{H, W1I, MROWS, 2 * DFF, DM}; pg8::StaticOrder S; S.init(MROWS, 2 * DFF, G, bx);
        pg8::EpiSwiglu E{ACT, DFF};
        pg8::gemm_phase<pg8::EpiSwiglu, pg8::StaticOrder, true, true>(ldsl, g, S, E);
        if (hi > 2) GRID_SYNC();
    }
    if (IN(2)) {
        pg8::Gemm g{ACT, W1O, MROWS, DM, DFF}; pg8::StaticOrder S; S.init(MROWS, DM, G, bx);
        pg8::EpiRes E{a.x, a.out, DM, 0.5f};
        pg8::gemm_phase<pg8::EpiRes, pg8::StaticOrder, false, true>(ldsl, g, S, E);
        if (hi > 3) GRID_SYNC();
    }
    if (IN(3)) {
        for (int m = gw; m < MROWS; m += NGW) norm_row(a.out + (size_t)m * DM, a.nmix, H + (size_t)m * DM, lane, WF, a.fbias, LOGF + (size_t)m * 8);
        if (hi > 4) GRID_SYNC();
    }
    if (IN(4)) {
        if (bx < 16 && wave == 0) {
            const int b = bx >> 3, h = bx & 7; const float* src = LOGF + ((size_t)b * SEQ + lane * 64) * 8 + h;
            float s = 0.f;
            for (int i = 0; i < 64; ++i) s += src[i * 8];
            float incl = s;
#pragma unroll
            for (int o = 1; o < 64; o <<= 1) { const float t = __shfl_up(incl, o); if (lane >= o) incl += t; }
            float run = incl - s; float* dst = CUM + (size_t)bx * SEQ + lane * 64;
            for (int i = 0; i < 64; ++i) { run += src[i * 8]; dst[i] = run; }
        }
        pg8::Gemm g{H, WIN, MROWS, NQKV, DM}; pg8::StaticOrder S; S.init(MROWS, NQKV, G, bx);
        pg8::EpiQKV E{ACT, NQKV, (const float*)(CTL + 256), (LAS float*)(ldsl + XCH_OFF)};
        pg8::gemm_phase<pg8::EpiQKV, pg8::StaticOrder, true, true>(ldsl, g, S, E);
        if (hi > 5) GRID_SYNC();
    }
    if (IN(5)) {
        LAS unsigned* misc = (LAS unsigned*)(ldsl + MISC_OFF);
        const bf16* QKV = ACT;
        for (;;) {
            if (tid == 0) misc[0] = atomicAdd(CTL, 1u);
            __syncthreads();
            const int ui = (int)misc[0];
            __syncthreads();
            if (ui >= 256 + 768) break;
            att::UnitD U;
            if (ui < 256) {
                const int qb = 15 - (ui >> 4), bh = ui & 15, b = bh >> 3, h = bh & 7;
                const bf16* base = QKV + (size_t)b * SEQ * NQKV;
                U.Q = base + 3072 + h * HD; U.K = base + 4096 + h * HD; U.V = base + 5120 + h * HD; U.pitch = NQKV;
                U.O = H + (size_t)b * SEQ * DM + 1024 + h * HD; U.opitch = DM;
                U.den = nullptr; U.mx = nullptr; U.spitch = 0; U.c = CUM + (size_t)bh * SEQ; U.rel = nullptr; U.head = h; U.dil = 1;
                U.q0 = qb * 256; U.jlo = 0; U.jhi = qb * 4 + 4; U.W = 0x7fffffff;
            } else {
                const int r = ui - 256, u16 = r & 15, pbh = r >> 4, bh = pbh & 15, p = pbh >> 4, b = bh >> 3, h = bh & 7;
                const int dil = (p == 0) ? 1 : (p == 1) ? 4 : 16;
                int z, n;
                if (p == 0) { z = 0; n = u16; } else if (p == 1) { z = u16 >> 2; n = u16 & 3; } else { z = u16; n = 0; }
                const bf16* base = QKV + ((size_t)b * SEQ + z) * NQKV;
                U.Q = base + h * HD; U.K = base + 1024 + h * HD; U.V = base + 2048 + h * HD; U.pitch = (size_t)dil * NQKV;
                U.O = OPART + (size_t)p * MROWS * 1024 + ((size_t)b * SEQ + z) * 1024 + h * HD; U.opitch = (size_t)dil * 1024;
                U.den = DEN + (size_t)p * MROWS * 8 + ((size_t)b * SEQ + z) * 8 + h; U.mx = MX + (size_t)p * MROWS * 8 + ((size_t)b * SEQ + z) * 8 + h; U.spitch = (size_t)dil * 8;
                U.c = nullptr; U.rel = a.rel; U.head = h; U.dil = dil;
                U.q0 = n * 256; U.jlo = (n == 0) ? 0 : n * 4 - 2; U.jhi = n * 4 + 4; U.W = 129;
            }
            att::attn_unit(U, (char*)lds);
        }
        if (hi > 6) GRID_SYNC();
    }
    if (IN(6)) {
        for (size_t gidx = (size_t)bx * NTHREADS + tid; gidx < (size_t)MROWS * 8 * 16; gidx += (size_t)G * NTHREADS) {
            const size_t pair = gidx >> 4; const int part = (int)(gidx & 15); const size_t token = pair >> 3; const int h = (int)(pair & 7);
            float mv[3], lv[3];
#pragma unroll
            for (int p = 0; p < 3; ++p) { mv[p] = MX[(size_t)p * MROWS * 8 + pair]; lv[p] = DEN[(size_t)p * MROWS * 8 + pair]; }
            const float mm = fmaxf(mv[0], fmaxf(mv[1], mv[2]));
            float wsum = 0.f, accv[8] = {0.f, 0.f, 0.f, 0.f, 0.f, 0.f, 0.f, 0.f};
#pragma unroll
            for (int p = 0; p < 3; ++p) {
                const float w = lv[p] * __builtin_amdgcn_exp2f((mv[p] - mm) * att::C2); wsum += w;
                const u32x4v q = *(const u32x4v*)(OPART + (size_t)p * MROWS * 1024 + token * 1024 + h * HD + part * 8);
                const unsigned qq[4] = {q.x, q.y, q.z, q.w};
#pragma unroll
                for (int j = 0; j < 4; ++j) { accv[2 * j] += w * __uint_as_float(qq[j] << 16); accv[2 * j + 1] += w * __uint_as_float(qq[j] & 0xffff0000u); }
            }
            const float inv = 1.0f / wsum;
            u32x4v o; o.x = pk2(accv[0] * inv, accv[1] * inv); o.y = pk2(accv[2] * inv, accv[3] * inv); o.z = pk2(accv[4] * inv, accv[5] * inv); o.w = pk2(accv[6] * inv, accv[7] * inv);
            *(u32x4v*)(H + token * DM + h * HD + part * 8) = o;
        }
        if (hi > 7) GRID_SYNC();
    }
    if (IN(7)) {
        pg8::Gemm g{H, WOUT, MROWS, DM, DM}; pg8::StaticOrder S; S.init(MROWS, DM, G, bx);
        pg8::EpiRes E{a.out, a.out, DM, 1.0f};
        pg8::gemm_phase<pg8::EpiRes, pg8::StaticOrder, false, true>(ldsl, g, S, E);
        if (hi > 8) GRID_SYNC();
    }
    if (IN(8)) {
        for (int m = gw; m < MROWS; m += NGW) norm_row(a.out + (size_t)m * DM, a.n2, H + (size_t)m * DM, lane, nullptr, nullptr, nullptr);
        if (hi > 9) GRID_SYNC();
    }
    if (IN(9)) {
        pg8::Gemm g{H, W2I, MROWS, 2 * DFF, DM}; pg8::StaticOrder S; S.init(MROWS, 2 * DFF, G, bx);
        pg8::EpiSwiglu E{ACT, DFF};
        pg8::gemm_phase<pg8::EpiSwiglu, pg8::StaticOrder, true, true>(ldsl, g, S, E);
        if (hi > 10) GRID_SYNC();
    }
    if (IN(10)) {
        pg8::Gemm g{ACT, W2O, MROWS, DM, DFF}; pg8::StaticOrder S; S.init(MROWS, DM, G, bx);
        pg8::EpiRes E{a.out, a.out, DM, 0.5f};
        pg8::gemm_phase<pg8::EpiRes, pg8::StaticOrder, false, true>(ldsl, g, S, E);
    }
#undef IN
}

extern "C" void kernel_launch(void* const* d_in, const int* in_sizes, int n_in, void* d_out, int out_size, void* d_ws, size_t ws_size, hipStream_t stream) {
    static int grid = 0;
    if (grid == 0) {
        int dev = 0, cus = 0, per_cu = 0;
        if (hipGetDevice(&dev) != hipSuccess || hipDeviceGetAttribute(&cus, hipDeviceAttributeMultiprocessorCount, dev) != hipSuccess) { fprintf(stderr, "kernel_launch: device query failed\n"); grid = -1; return; }
        if (hipFuncSetAttribute((const void*)hybrid_fwd, hipFuncAttributeMaxDynamicSharedMemorySize, LDS_BYTES) != hipSuccess) { fprintf(stderr, "kernel_launch: hipFuncSetAttribute failed\n"); grid = -1; return; }
        if (hipOccupancyMaxActiveBlocksPerMultiprocessor(&per_cu, (const void*)hybrid_fwd, NTHREADS, LDS_BYTES) != hipSuccess || per_cu < 1) fprintf(stderr, "kernel_launch: occupancy query says %d\n", per_cu);
        (void)hipGetLastError();
        if (ws_size < WS_END) { fprintf(stderr, "kernel_launch: workspace too small (%zu < %zu)\n", ws_size, (size_t)WS_END); grid = -1; return; }
        grid = cus;
    }
    if (grid < 0) return;
    Args a{};
    a.x = (const float*)d_in[0]; a.n1 = (const float*)d_in[1]; a.w1i = (const float*)d_in[2]; a.w1o = (const float*)d_in[3]; a.nmix = (const float*)d_in[4];
    a.win = (const float*)d_in[5]; a.gains[0] = (const float*)d_in[6]; a.gains[1] = (const float*)d_in[7]; a.gains[2] = (const float*)d_in[8]; a.gains[3] = (const float*)d_in[9];
    a.fbias = (const float*)d_in[10]; a.rel = (const float*)d_in[11]; a.wout = (const float*)d_in[12]; a.n2 = (const float*)d_in[13]; a.w2i = (const float*)d_in[14]; a.w2o = (const float*)d_in[15];
    a.out = (float*)d_out; a.ws = (unsigned char*)d_ws;
#if MK_MULTI
    for (int p = 0; p <= 10; ++p) { a.ph_lo = p; a.ph_hi = p + 1; hipLaunchKernelGGL(hybrid_fwd, dim3(grid), dim3(NTHREADS), LDS_BYTES, stream, a); }
#else
    a.ph_lo = 0; a.ph_hi = 11;
    void* args[] = {&a};
    hipError_t e = hipLaunchCooperativeKernel((const void*)hybrid_fwd, dim3(grid), dim3(NTHREADS), args, LDS_BYTES, stream);
    if (e != hipSuccess) fprintf(stderr, "kernel_launch: cooperative launch failed: %s (grid %d)\n", hipGetErrorString(e), grid);
#endif
}
```

```cpp
#include <hip/hip_runtime.h>
#include <cstdio>
#include <cstdint>

#ifndef MK_MULTI
#define MK_MULTI 0
#endif

namespace pg8 {
#define PG8_LAS __attribute__((address_space(3)))
typedef unsigned short bf16_t;
typedef short bf16x8 __attribute__((ext_vector_type(8)));
typedef float f32x4 __attribute__((ext_vector_type(4)));
typedef unsigned u32x4 __attribute__((ext_vector_type(4)));
constexpr int BM = 256, BK = 64, HALF = 128, HTB = HALF * BK * 2  , STAGE_BYTES = 8 * HTB, NXCD = 8, WGM = 8;

__host__ __device__ __forceinline__ int lds_byte(int r, int c) { const int st = (r >> 4) * 2 + (c >> 5), rr = r & 15, cc = c & 31, ob = rr * 64 + cc * 2; return st * 1024 + (ob ^ (((ob >> 9) & 1) << 5)); }
__host__ __device__ __forceinline__ void stage_rc(int b, int& R, int& C) { const int st = b / 1024, sb = b % 1024, swz = sb ^ (((sb >> 9) & 1) << 5); R = (st >> 1) * 16 + swz / 64; C = (st & 1) * 32 + (swz % 64) / 2; }
__host__ __device__ __forceinline__ int perm32(int rho) { const int n = rho >> 4, i = rho & 15; return 8 * (i >> 2) + 4 * n + (i & 3); }

struct Unit { int pm, pn, ord; };
struct Gemm { const bf16_t* A; const bf16_t* Bt; int M, N, K; };

struct StaticOrder {
    int nM, nN, nwg, G, c;
    __host__ __device__ void init(int M, int N, int G_, int c_) { nM = M / BM; nN = N / BM; nwg = nM * nN; G = G_; c = c_; }
    __host__ __device__ __forceinline__ bool next(int i, Unit& u) const {
        const long L = (long)i * G + c; if (L >= nwg) return false;
        int wgid = (int)L; { const int q = nwg / NXCD, r = nwg % NXCD, xcd = wgid % NXCD, off = wgid / NXCD; wgid = (xcd < r ? xcd * (q + 1) : r * (q + 1) + (xcd - r) * q) + off; }
        const int nig = WGM * nN, gid = wgid / nig, fm = gid * WGM, gsz = (nM - fm) < WGM ? (nM - fm) : WGM;
        u.pm = fm + ((wgid % nig) % gsz); u.pn = (wgid % nig) / gsz; u.ord = i; return true;
    }
    __device__ __forceinline__ void a_ready(const Unit&) const {}
    __device__ __forceinline__ void done(const Unit&) const {}
};

__device__ __forceinline__ unsigned cvt_pk_bf16(float lo, float hi) { unsigned r; asm volatile("v_cvt_pk_bf16_f32 %0, %1, %2" : "=v"(r) : "v"(lo), "v"(hi)); return r; }


typedef float f32x2 __attribute__((ext_vector_type(2)));

__device__ __forceinline__ float row_rstd8(const float* PSS, int row, int fq) {
    const f32x2 p = *(const f32x2*)(PSS + (size_t)row * 8 + 2 * fq); float s = p.x + p.y;
    s += __shfl_xor(s, 16); s += __shfl_xor(s, 32);
    return __builtin_amdgcn_rsqf(s * (1.0f / 2048.0f) + 1e-6f);
}
struct EpiSwiglu {
    static constexpr bool PERM = true, AFTER_DRAIN = false;
    bf16_t* O; int ldc; const PG8_LAS float* RS;
    __device__ __forceinline__ void operator()(const f32x4 (&acc)[2][2][4][2], const Unit& u, int wr, int wc, int fr, int fq) const {
        const int row0 = u.pm * BM + wr * 64 + fr, col0 = u.pn * HALF + wc * 32 + 8 * fq;
        float rsd[2][4];
#pragma unroll
        for (int ai = 0; ai < 2; ++ai)
#pragma unroll
            for (int m = 0; m < 4; ++m) rsd[ai][m] = RS ? RS[u.ord * 256 + ai * HALF + wr * 64 + m * 16 + fr] : 1.0f;
#pragma unroll
        for (int ai = 0; ai < 2; ++ai)
#pragma unroll
            for (int m = 0; m < 4; ++m) {
                bf16_t* rowp = O + (size_t)(row0 + ai * HALF + m * 16) * ldc + col0;
                float r[8];
#pragma unroll
                for (int n = 0; n < 2; ++n)
#pragma unroll
                    for (int j = 0; j < 4; ++j) {
                        const float g = acc[ai][0][m][n][j] * rsd[ai][m], up = acc[ai][1][m][n][j] * rsd[ai][m];
                        const float e = __builtin_amdgcn_exp2f(-1.4426950408889634f * g);
                        r[n * 4 + j] = g * __builtin_amdgcn_rcpf(1.0f + e) * up;
                    }
                u32x4 w; w.x = cvt_pk_bf16(r[0], r[1]); w.y = cvt_pk_bf16(r[2], r[3]); w.z = cvt_pk_bf16(r[4], r[5]); w.w = cvt_pk_bf16(r[6], r[7]);
                *(u32x4*)rowp = w;
            }
    }
};
struct EpiRes {
    static constexpr bool PERM = false, AFTER_DRAIN = false;
    const float* base; float* out; int ldc; float scale;
    __device__ __forceinline__ void operator()(const f32x4 (&acc)[2][2][4][2], const Unit& u, int wr, int wc, int fr, int fq) const {
        const int row0 = u.pm * BM + wr * 64 + fr, col0 = u.pn * BM + wc * 32 + 4 * fq;
        f32x4 bq[2][2][2];
#pragma unroll
        for (int bj = 0; bj < 2; ++bj)
#pragma unroll
            for (int n = 0; n < 2; ++n) bq[0][bj][n] = __builtin_nontemporal_load((const f32x4*)(base + (size_t)row0 * ldc + col0 + bj * HALF + n * 16));
#pragma unroll
        for (int it = 0; it < 8; ++it) {
            const int ai = it >> 2, m = it & 3;
            const size_t off = (size_t)(row0 + ai * HALF + m * 16) * ldc + col0;
            if (it + 1 < 8) { const size_t offn = (size_t)(row0 + ((it + 1) >> 2) * HALF + ((it + 1) & 3) * 16) * ldc + col0;
#pragma unroll
                for (int bj = 0; bj < 2; ++bj)
#pragma unroll
                    for (int n = 0; n < 2; ++n) bq[(it + 1) & 1][bj][n] = __builtin_nontemporal_load((const f32x4*)(base + offn + bj * HALF + n * 16)); }
#pragma unroll
            for (int bj = 0; bj < 2; ++bj)
#pragma unroll
                for (int n = 0; n < 2; ++n) __builtin_nontemporal_store(bq[it & 1][bj][n] + acc[ai][bj][m][n] * scale, (f32x4*)(out + off + bj * HALF + n * 16));
        }
    }
};
struct EpiResNorm {
    static constexpr bool PERM = false, AFTER_DRAIN = true;
    const float* base; float* out; int ldc; float scale; const float* gain; bf16_t* XG; float* PSS;
    __device__ __forceinline__ void fused(const f32x4 (&acc)[2][2][4][2], const Unit& u, int wr, int wc, int fr, int fq, PG8_LAS unsigned char* lds, int wid, int lane) const {
        typedef unsigned u32x2 __attribute__((ext_vector_type(2)));
        const int row0 = u.pm * BM + wr * 64 + fr, col0 = u.pn * BM + wc * 32 + 4 * fq;
        PG8_LAS float* P = (PG8_LAS float*)lds;
        f32x4 gv[2][2];
#pragma unroll
        for (int bj = 0; bj < 2; ++bj)
#pragma unroll
            for (int n = 0; n < 2; ++n) gv[bj][n] = *(const f32x4*)(gain + col0 + bj * HALF + n * 16);
        f32x4 bq[2][2][2];
#pragma unroll
        for (int bj = 0; bj < 2; ++bj)
#pragma unroll
            for (int n = 0; n < 2; ++n) bq[0][bj][n] = __builtin_nontemporal_load((const f32x4*)(base + (size_t)row0 * ldc + col0 + bj * HALF + n * 16));
#pragma unroll
        for (int it = 0; it < 8; ++it) {
            const int ai = it >> 2, m = it & 3;
            const size_t off = (size_t)(row0 + ai * HALF + m * 16) * ldc + col0;
            if (it + 1 < 8) { const size_t offn = (size_t)(row0 + ((it + 1) >> 2) * HALF + ((it + 1) & 3) * 16) * ldc + col0;
#pragma unroll
                for (int bj = 0; bj < 2; ++bj)
#pragma unroll
                    for (int n = 0; n < 2; ++n) bq[(it + 1) & 1][bj][n] = __builtin_nontemporal_load((const f32x4*)(base + offn + bj * HALF + n * 16)); }
            float ss = 0.f;
#pragma unroll
            for (int bj = 0; bj < 2; ++bj)
#pragma unroll
                for (int n = 0; n < 2; ++n) {
                    const f32x4 x1 = bq[it & 1][bj][n] + acc[ai][bj][m][n] * scale;
                    *(f32x4*)(out + off + bj * HALF + n * 16) = x1;
                    ss += (x1[0] * x1[0] + x1[1] * x1[1]) + (x1[2] * x1[2] + x1[3] * x1[3]);
                    const f32x4 xg = x1 * gv[bj][n];
                    u32x2 w; w.x = cvt_pk_bf16(xg[0], xg[1]); w.y = cvt_pk_bf16(xg[2], xg[3]);
                    *(u32x2*)(XG + off + bj * HALF + n * 16) = w;
                }
            ss += __shfl_xor(ss, 16); ss += __shfl_xor(ss, 32);
            if (fq == 0) P[(ai * HALF + wr * 64 + m * 16 + fr) * 4 + wc] = ss;
        }
        asm volatile("s_waitcnt lgkmcnt(0)" ::: "memory"); __builtin_amdgcn_s_barrier(); asm volatile("" ::: "memory");
        const int t = wid * 64 + lane;
        if (t < 256) { const f32x4 p = *(const PG8_LAS f32x4*)(P + t * 4); PSS[(size_t)(u.pm * BM + t) * 8 + u.pn] = (p[0] + p[1]) + (p[2] + p[3]); }
    }
};
__device__ __forceinline__ void bf8_to_f32(const u32x4 q, float (&f)[8]) {
    f[0] = __uint_as_float(q.x << 16); f[1] = __uint_as_float(q.x & 0xffff0000u); f[2] = __uint_as_float(q.y << 16); f[3] = __uint_as_float(q.y & 0xffff0000u);
    f[4] = __uint_as_float(q.z << 16); f[5] = __uint_as_float(q.z & 0xffff0000u); f[6] = __uint_as_float(q.w << 16); f[7] = __uint_as_float(q.w & 0xffff0000u);
}
template <bool BASE16> struct EpiResNorm2 {
    static constexpr bool PERM = true, AFTER_DRAIN = true;
    const void* base; bf16_t* XB; int ldc; float scale; float* PSS;
    __device__ __forceinline__ void fused(const f32x4 (&acc)[2][2][4][2], const Unit& u, int wr, int wc, int fr, int fq, PG8_LAS unsigned char* lds, int wid, int lane) const {
        const int row0 = u.pm * BM + wr * 64 + fr, col0 = u.pn * BM + wc * 32 + 8 * fq;
        PG8_LAS float* P = (PG8_LAS float*)lds;
        u32x4 b16[2][2]; f32x4 b32[2][2][2];
#define ERN_LOAD(slot_, off_) do { _Pragma("unroll") for (int bj = 0; bj < 2; ++bj) {                                                                \
            if constexpr (BASE16) b16[slot_][bj] = __builtin_nontemporal_load((const u32x4*)((const bf16_t*)base + (off_) + bj * HALF));            \
            else { b32[slot_][bj][0] = __builtin_nontemporal_load((const f32x4*)((const float*)base + (off_) + bj * HALF));                         \
                   b32[slot_][bj][1] = __builtin_nontemporal_load((const f32x4*)((const float*)base + (off_) + bj * HALF + 4)); } } } while (0)
        ERN_LOAD(0, (size_t)row0 * ldc + col0);
#pragma unroll
        for (int it = 0; it < 8; ++it) {
            const int ai = it >> 2, m = it & 3;
            const size_t off = (size_t)(row0 + ai * HALF + m * 16) * ldc + col0;
            if (it + 1 < 8) { const size_t offn = (size_t)(row0 + ((it + 1) >> 2) * HALF + ((it + 1) & 3) * 16) * ldc + col0; ERN_LOAD((it + 1) & 1, offn); }
            float ss = 0.f;
#pragma unroll
            for (int bj = 0; bj < 2; ++bj) {
                float bv[8];
                if constexpr (BASE16) bf8_to_f32(b16[it & 1][bj], bv);
                else { const f32x4 t0 = b32[it & 1][bj][0], t1 = b32[it & 1][bj][1]; bv[0] = t0[0]; bv[1] = t0[1]; bv[2] = t0[2]; bv[3] = t0[3]; bv[4] = t1[0]; bv[5] = t1[1]; bv[6] = t1[2]; bv[7] = t1[3]; }
                float x1[8];
#pragma unroll
                for (int j = 0; j < 4; ++j) { x1[j] = bv[j] + acc[ai][bj][m][0][j] * scale; x1[4 + j] = bv[4 + j] + acc[ai][bj][m][1][j] * scale; }
#pragma unroll
                for (int j = 0; j < 8; ++j) ss += x1[j] * x1[j];
                u32x4 wb; wb.x = cvt_pk_bf16(x1[0], x1[1]); wb.y = cvt_pk_bf16(x1[2], x1[3]); wb.z = cvt_pk_bf16(x1[4], x1[5]); wb.w = cvt_pk_bf16(x1[6], x1[7]);
                *(u32x4*)(XB + off + bj * HALF) = wb;
            }
            ss += __shfl_xor(ss, 16); ss += __shfl_xor(ss, 32);
            if (fq == 0) P[(ai * HALF + wr * 64 + m * 16 + fr) * 4 + wc] = ss;
        }
#undef ERN_LOAD
        asm volatile("s_waitcnt lgkmcnt(0)" ::: "memory"); __builtin_amdgcn_s_barrier(); asm volatile("" ::: "memory");
        const int t = wid * 64 + lane;
        if (t < 256) { const f32x4 p = *(const PG8_LAS f32x4*)(P + t * 4); PSS[(size_t)(u.pm * BM + t) * 8 + u.pn] = (p[0] + p[1]) + (p[2] + p[3]); }
    }
};
struct EpiRes2 {
    static constexpr bool PERM = true, AFTER_DRAIN = false;
    const bf16_t* base; float* out; int ldc; float scale;
    __device__ __forceinline__ void operator()(const f32x4 (&acc)[2][2][4][2], const Unit& u, int wr, int wc, int fr, int fq) const {
        const int row0 = u.pm * BM + wr * 64 + fr, col0 = u.pn * BM + wc * 32 + 8 * fq;
        u32x4 bq[2][2];
#pragma unroll
        for (int bj = 0; bj < 2; ++bj) bq[0][bj] = __builtin_nontemporal_load((const u32x4*)(base + (size_t)row0 * ldc + col0 + bj * HALF));
#pragma unroll
        for (int it = 0; it < 8; ++it) {
            const int ai = it >> 2, m = it & 3;
            const size_t off = (size_t)(row0 + ai * HALF + m * 16) * ldc + col0;
            if (it + 1 < 8) { const size_t offn = (size_t)(row0 + ((it + 1) >> 2) * HALF + ((it + 1) & 3) * 16) * ldc + col0;
#pragma unroll
                for (int bj = 0; bj < 2; ++bj) bq[(it + 1) & 1][bj] = __builtin_nontemporal_load((const u32x4*)(base + offn + bj * HALF)); }
#pragma unroll
            for (int bj = 0; bj < 2; ++bj) { float bv[8]; bf8_to_f32(bq[it & 1][bj], bv);
                const f32x4 o0 = {bv[0] + acc[ai][bj][m][0][0] * scale, bv[1] + acc[ai][bj][m][0][1] * scale, bv[2] + acc[ai][bj][m][0][2] * scale, bv[3] + acc[ai][bj][m][0][3] * scale};
                const f32x4 o1 = {bv[4] + acc[ai][bj][m][1][0] * scale, bv[5] + acc[ai][bj][m][1][1] * scale, bv[6] + acc[ai][bj][m][1][2] * scale, bv[7] + acc[ai][bj][m][1][3] * scale};
                __builtin_nontemporal_store(o0, (f32x4*)(out + off + bj * HALF)); __builtin_nontemporal_store(o1, (f32x4*)(out + off + bj * HALF + 4)); }
        }
    }
};
struct EpiQKV {
    static constexpr bool PERM = true, AFTER_DRAIN = false;
    bf16_t* O; int ldc; const PG8_LAS float* gains; const PG8_LAS float* RS;
    PG8_LAS float* xch;
    __device__ __forceinline__ void operator()(const f32x4 (&acc)[2][2][4][2], const Unit& u, int wr, int wc, int fr, int fq) const {
        const int seg = u.pn >> 2;
        const bool norm = (seg != 2) && (seg != 5);
        const int row0 = u.pm * BM + wr * 64 + fr, col0 = u.pn * BM + wc * 32 + 8 * fq;
        float rsd[2][4];
#pragma unroll
        for (int ai = 0; ai < 2; ++ai)
#pragma unroll
            for (int m = 0; m < 4; ++m) rsd[ai][m] = RS[u.ord * 256 + ai * HALF + wr * 64 + m * 16 + fr];
        if (norm) {
#pragma unroll
            for (int ai = 0; ai < 2; ++ai)
#pragma unroll
                for (int m = 0; m < 4; ++m)
#pragma unroll
                    for (int bj = 0; bj < 2; ++bj) {
                        const f32x4 a = acc[ai][bj][m][0], b = acc[ai][bj][m][1];
                        float s = (a[0] * a[0] + a[1] * a[1]) + (a[2] * a[2] + a[3] * a[3]) + (b[0] * b[0] + b[1] * b[1]) + (b[2] * b[2] + b[3] * b[3]);
                        s += __shfl_xor(s, 16); s += __shfl_xor(s, 32);
                        if (fq == 0) xch[((ai * HALF + wr * 64 + m * 16 + fr) * 2 + bj) * 4 + wc] = s;
                    }
            asm volatile("s_waitcnt lgkmcnt(0)" ::: "memory"); __builtin_amdgcn_s_barrier(); asm volatile("" ::: "memory");
            const int gi = (seg == 0) ? 0 : (seg == 1) ? 1 : (seg == 3) ? 2 : 3;
            const PG8_LAS float* gp = gains + gi * 128 + wc * 32 + 8 * fq;
            const f32x4 g0 = *(const PG8_LAS f32x4*)gp, g1 = *(const PG8_LAS f32x4*)(gp + 4);
#pragma unroll
            for (int ai = 0; ai < 2; ++ai)
#pragma unroll
                for (int m = 0; m < 4; ++m) {
                    bf16_t* rowp = O + (size_t)(row0 + ai * HALF + m * 16) * ldc + col0;
#pragma unroll
                    for (int bj = 0; bj < 2; ++bj) {
                        const f32x4 p = *(const PG8_LAS f32x4*)(xch + ((ai * HALF + wr * 64 + m * 16 + fr) * 2 + bj) * 4);
                        const float rs = rsd[ai][m] * __builtin_amdgcn_rsqf(((p[0] + p[1]) + (p[2] + p[3])) * (1.0f / 128.0f) * (rsd[ai][m] * rsd[ai][m]) + 1e-6f);
                        const f32x4 v0 = acc[ai][bj][m][0] * g0 * rs, v1 = acc[ai][bj][m][1] * g1 * rs;
                        u32x4 w; w.x = cvt_pk_bf16(v0[0], v0[1]); w.y = cvt_pk_bf16(v0[2], v0[3]); w.z = cvt_pk_bf16(v1[0], v1[1]); w.w = cvt_pk_bf16(v1[2], v1[3]);
                        *(u32x4*)(rowp + bj * HALF) = w;
                    }
                    asm volatile("" ::: "memory");
                }
        } else {
#pragma unroll
            for (int ai = 0; ai < 2; ++ai)
#pragma unroll
                for (int m = 0; m < 4; ++m) {
                    bf16_t* rowp = O + (size_t)(row0 + ai * HALF + m * 16) * ldc + col0;
#pragma unroll
                    for (int bj = 0; bj < 2; ++bj) {
                        const f32x4 v0 = acc[ai][bj][m][0] * rsd[ai][m], v1 = acc[ai][bj][m][1] * rsd[ai][m];
                        u32x4 w; w.x = cvt_pk_bf16(v0[0], v0[1]); w.y = cvt_pk_bf16(v0[2], v0[3]); w.z = cvt_pk_bf16(v1[0], v1[1]); w.w = cvt_pk_bf16(v1[2], v1[3]);
                        *(u32x4*)(rowp + bj * HALF) = w;
                    }
                }
        }
    }
};

#ifdef PROBE_EPI
#define PG8_EPI_T0() const unsigned long long epi_t0_ = __builtin_amdgcn_s_memrealtime()
#define PG8_EPI_T1() do { atomicAdd((unsigned*)(lds + 131072 + 8192 + 64), (unsigned)(__builtin_amdgcn_s_memrealtime() - epi_t0_)); } while (0)
#else
#define PG8_EPI_T0() do {} while (0)
#define PG8_EPI_T1() do {} while (0)
#endif
template <class Epi, class Sched, bool ALIGN_EPI = false, bool SP2 = false>
__device__ __forceinline__ void gemm_phase(PG8_LAS unsigned char* lds, const Gemm g, const Sched& S, const Epi& E) {
    const int tid = threadIdx.x, wid = __builtin_amdgcn_readfirstlane(tid >> 6), lane = tid & 63, wr = wid >> 2, wc = wid & 3, fr = lane & 15, fq = lane >> 4;
    const int K = g.K, nt = K / BK;
    unsigned voffA[2], voffB[2];
#pragma unroll
    for (int i = 0; i < 2; ++i) { int R, C; stage_rc(tid * 16 + i * 8192, R, C); const int Rb = Epi::PERM ? ((R & ~31) + perm32(R & 31)) : R;
        voffA[i] = (unsigned)(R * K + C) * 2u; voffB[i] = (unsigned)(Rb * K + C) * 2u; }
    const size_t kstep = (size_t)(BK * 2);
    const size_t hstep = (size_t)HALF * K * 2;
    const size_t tstep = 2 * hstep;
    const unsigned ldsw = (unsigned)wid * 1024u;
    const int aoff = lds_byte(wr * 64 + fr, fq * 8), boff = lds_byte(wc * 32 + fr, fq * 8);
#define PG8_SA(b, h) (((b) * 2 + (h)) * HTB)
#define PG8_SB(b, h) ((4 + (b) * 2 + (h)) * HTB)
#define PG8_STAGE(bufoff, gbase, voff) do { _Pragma("unroll") for (int _i = 0; _i < 2; ++_i) \
        __builtin_amdgcn_global_load_lds((const unsigned*)((const char*)(gbase) + (voff)[_i]), (PG8_LAS unsigned*)(lds + (bufoff) + ldsw + _i * 8192), 16, 0, 0); } while (0)
#define PG8_LDA(dst, b, h) do { _Pragma("unroll") for (int m = 0; m < 4; ++m) _Pragma("unroll") for (int k = 0; k < 2; ++k) dst[m][k] = *(const PG8_LAS bf16x8*)(lds + PG8_SA(b, h) + aoff + m * 2048 + k * 1024); } while (0)
#define PG8_LDB(dst, b, h) do { _Pragma("unroll") for (int n = 0; n < 2; ++n) _Pragma("unroll") for (int k = 0; k < 2; ++k) dst[n][k] = *(const PG8_LAS bf16x8*)(lds + PG8_SB(b, h) + boff + n * 2048 + k * 1024); } while (0)
#define PG8_MMA(ai, bj, At, Bt) do { __builtin_amdgcn_s_setprio(1); _Pragma("unroll") for (int m = 0; m < 4; ++m) _Pragma("unroll") for (int n = 0; n < 2; ++n) _Pragma("unroll") for (int k = 0; k < 2; ++k) \
        acc[ai][bj][m][n] = __builtin_amdgcn_mfma_f32_16x16x32_bf16(Bt[n][k], At[m][k], acc[ai][bj][m][n], 0, 0, 0); __builtin_amdgcn_s_setprio(0); } while (0)
#define PG8_WAIT_V(n) asm volatile("s_waitcnt vmcnt(" #n ")" ::: "memory")
#define PG8_WAIT_L(n) asm volatile("s_waitcnt lgkmcnt(" #n ")" ::: "memory")
#define PG8_BAR __builtin_amdgcn_s_barrier()
#define PG8_SCHED __builtin_amdgcn_sched_barrier(0)
    Unit cur, nxt; int ui = 0;
    if (!S.next(0, cur)) return;
    f32x4 acc[2][2][4][2];
#pragma unroll
    for (int a = 0; a < 2; ++a)
#pragma unroll
        for (int b = 0; b < 2; ++b)
#pragma unroll
            for (int m = 0; m < 4; ++m)
#pragma unroll
                for (int n = 0; n < 2; ++n) acc[a][b][m][n] = (f32x4){0.f, 0.f, 0.f, 0.f};
    bf16x8 At[4][2], B0[2][2], B1[2][2];
    const char* cA = (const char*)g.A + (size_t)cur.pm * tstep; const char* cB = (const char*)g.Bt + (size_t)cur.pn * tstep;
    S.a_ready(cur);
    if constexpr (SP2) {
        PG8_STAGE(PG8_SB(0, 0), cB, voffB); PG8_STAGE(PG8_SB(0, 1), cB + hstep, voffB); PG8_STAGE(PG8_SA(0, 0), cA, voffA); PG8_STAGE(PG8_SA(0, 1), cA + hstep, voffA);
        if (wr == 1) PG8_BAR;
        PG8_WAIT_V(2); PG8_BAR;
        PG8_STAGE(PG8_SB(1, 0), cB + kstep, voffB); PG8_STAGE(PG8_SA(1, 0), cA + kstep, voffA); PG8_STAGE(PG8_SB(1, 1), cB + hstep + kstep, voffB);
        PG8_WAIT_V(6); PG8_BAR;
    } else {
        PG8_STAGE(PG8_SB(0, 0), cB, voffB); PG8_STAGE(PG8_SA(0, 0), cA, voffA); PG8_STAGE(PG8_SB(0, 1), cB + hstep, voffB); PG8_STAGE(PG8_SA(0, 1), cA + hstep, voffA);
        if (wr == 1) PG8_BAR;
        PG8_WAIT_V(4); PG8_BAR;
        PG8_STAGE(PG8_SB(1, 0), cB + kstep, voffB); PG8_STAGE(PG8_SA(1, 0), cA + kstep, voffA); PG8_STAGE(PG8_SB(1, 1), cB + hstep + kstep, voffB);
        PG8_WAIT_V(6); PG8_BAR;
    }
    for (;;) {
        const bool has_next = S.next(ui + 1, nxt);
        const char* nA = has_next ? (const char*)g.A + (size_t)nxt.pm * tstep : cA; const char* nB = has_next ? (const char*)g.Bt + (size_t)nxt.pn * tstep : cB;
        for (int t = 0; t < nt; t += 2) {
            const bool last = (t == nt - 2);
            const char* a1 = cA + (size_t)(t + 1) * kstep;
            const char* a2 = last ? nA : cA + (size_t)(t + 2) * kstep; const char* b2 = last ? nB : cB + (size_t)(t + 2) * kstep;
            const char* a3 = a2 + kstep; const char* b3 = b2 + kstep;
            if (last && has_next) S.a_ready(nxt);
            if constexpr (SP2) {
            PG8_LDB(B0, 0, 0); PG8_LDB(B1, 0, 1); PG8_SCHED; PG8_LDA(At, 0, 0); PG8_STAGE(PG8_SA(1, 1), a1 + hstep, voffA);
            PG8_WAIT_V(8); PG8_WAIT_L(0); PG8_BAR; PG8_MMA(0, 0, At, B0); PG8_MMA(0, 1, At, B1); PG8_BAR; PG8_SCHED;
            PG8_LDA(At, 0, 1); PG8_STAGE(PG8_SB(0, 0), b2, voffB); PG8_STAGE(PG8_SB(0, 1), b2 + hstep, voffB); PG8_STAGE(PG8_SA(0, 0), a2, voffA);
            PG8_WAIT_V(8); PG8_WAIT_L(0); PG8_BAR; PG8_MMA(1, 0, At, B0); PG8_MMA(1, 1, At, B1); PG8_BAR; PG8_SCHED;
            PG8_LDB(B0, 1, 0); PG8_LDB(B1, 1, 1); PG8_SCHED; PG8_LDA(At, 1, 0); PG8_STAGE(PG8_SA(0, 1), a2 + hstep, voffA);
            PG8_WAIT_V(8); PG8_WAIT_L(0); PG8_BAR; PG8_MMA(0, 0, At, B0); PG8_MMA(0, 1, At, B1); PG8_BAR; PG8_SCHED;
            PG8_LDA(At, 1, 1); PG8_STAGE(PG8_SB(1, 0), b3, voffB); PG8_STAGE(PG8_SB(1, 1), b3 + hstep, voffB); PG8_STAGE(PG8_SA(1, 0), a3, voffA);
            PG8_WAIT_V(8); PG8_WAIT_L(0); PG8_BAR; PG8_MMA(1, 0, At, B0); PG8_MMA(1, 1, At, B1); PG8_BAR; PG8_SCHED;
            } else {
            PG8_LDB(B0, 0, 0); PG8_SCHED; PG8_LDA(At, 0, 0); PG8_STAGE(PG8_SA(1, 1), a1 + hstep, voffA);
            PG8_WAIT_L(8); PG8_BAR; PG8_WAIT_L(0); PG8_MMA(0, 0, At, B0); PG8_BAR; PG8_SCHED;
            PG8_LDB(B1, 0, 1); PG8_STAGE(PG8_SB(0, 0), b2, voffB);
            PG8_BAR; PG8_WAIT_L(0); PG8_MMA(0, 1, At, B1); PG8_BAR;
            PG8_LDA(At, 0, 1); PG8_STAGE(PG8_SA(0, 0), a2, voffA);
            PG8_BAR; PG8_WAIT_L(0); PG8_MMA(1, 0, At, B0); PG8_BAR; PG8_SCHED;
            PG8_STAGE(PG8_SB(0, 1), b2 + hstep, voffB);
            PG8_WAIT_V(6); PG8_BAR; PG8_MMA(1, 1, At, B1); PG8_BAR;
            PG8_LDB(B0, 1, 0); PG8_SCHED; PG8_LDA(At, 1, 0); PG8_STAGE(PG8_SA(0, 1), a2 + hstep, voffA);
            PG8_WAIT_L(8); PG8_BAR; PG8_WAIT_L(0); PG8_MMA(0, 0, At, B0); PG8_BAR; PG8_SCHED;
            PG8_LDB(B1, 1, 1); PG8_STAGE(PG8_SB(1, 0), b3, voffB);
            PG8_BAR; PG8_WAIT_L(0); PG8_MMA(0, 1, At, B1); PG8_BAR;
            PG8_LDA(At, 1, 1); PG8_STAGE(PG8_SA(1, 0), a3, voffA);
            PG8_BAR; PG8_WAIT_L(0); PG8_MMA(1, 0, At, B0); PG8_BAR; PG8_SCHED;
            PG8_STAGE(PG8_SB(1, 1), b3 + hstep, voffB);
            PG8_WAIT_V(6); PG8_BAR; PG8_MMA(1, 1, At, B1); PG8_BAR;
            }
        }
        if constexpr (ALIGN_EPI) { if (wr == 0) PG8_BAR; }
        if constexpr (!Epi::AFTER_DRAIN) { PG8_EPI_T0(); E(acc, cur, wr, wc, fr, fq); PG8_EPI_T1(); S.done(cur); }
        if (!has_next) break;
#pragma unroll
        for (int a = 0; a < 2; ++a)
#pragma unroll
            for (int b = 0; b < 2; ++b)
#pragma unroll
                for (int m = 0; m < 4; ++m)
#pragma unroll
                    for (int n = 0; n < 2; ++n) acc[a][b][m][n] = (f32x4){0.f, 0.f, 0.f, 0.f};
        cur = nxt; cA = nA; cB = nB; ++ui;
        if constexpr (ALIGN_EPI) { if (wr == 1) PG8_BAR; }
    }
    PG8_WAIT_V(0);
    if constexpr (!ALIGN_EPI) { if (wr == 0) PG8_BAR; }
    PG8_BAR;
    if constexpr (Epi::AFTER_DRAIN) { E.fused(acc, cur, wr, wc, fr, fq, lds, wid, lane); S.done(cur); }
#undef PG8_SA
#undef PG8_SB
#undef PG8_STAGE
#undef PG8_LDA
#undef PG8_LDB
#undef PG8_MMA
#undef PG8_WAIT_V
#undef PG8_WAIT_L
#undef PG8_BAR
#undef PG8_SCHED
}

}

namespace att {
typedef unsigned short bf16;
typedef short bf16x8 __attribute__((ext_vector_type(8)));
typedef short s16x4 __attribute__((ext_vector_type(4)));
typedef float f32x16 __attribute__((ext_vector_type(16)));
typedef float f32x4 __attribute__((ext_vector_type(4)));
typedef unsigned u32x4 __attribute__((ext_vector_type(4)));
constexpr float SCALE = 0.08838834764831845f, INV_SCALE = 11.313708498984761f, THR = 8.f;
constexpr float C2 = 1.4426950408889634f * SCALE;
constexpr int NW = 8, QBLK = 32, KVBLK = 64, QB = NW * QBLK, D = 128;
constexpr int SHM_V = KVBLK * D * 2, SHM_K = KVBLK * D * 2;
constexpr int NBUF = 3, L_K = 0, L_V = NBUF * SHM_K, L_WS = L_V + NBUF * SHM_V, L_TB = L_WS + NW * 64 * 4, TB_N = 352, TB_PAD = 96, L_CB = L_TB + TB_N * 4, L_WT = L_CB + 4096 * 4, L_END = L_WT + 64;
static_assert(L_END <= 131072 && (L_CB % 16) == 0, "attention LDS map");

#define KSWZ(row, colB) ((row) * 256 + ((colB) ^ (((row) & 7) << 4)))
#define SBAR() __builtin_amdgcn_sched_barrier(0)
__device__ __forceinline__ int v_st(int k, int c) { const int kk = (k & ~0xC) | ((k & 4) << 1) | ((k & 8) >> 1); return ((kk >> 3) * 4 + (c >> 5)) * 512 + ((kk & 7) * 32 + (c & 31)) * 2; }
__device__ __forceinline__ int v_rd_base(int lane) { return ((lane & 3) << 3) | (((lane >> 2) & 3) << 6) | (((lane >> 4) & 1) << 5) | (((lane >> 5) & 1) << 8); }
constexpr int v_rd_off(int d0, int ks, int half) { return d0 * 512 + ks * 4096 + half * 2048; }
__device__ __forceinline__ int crow(int r, int hi) { return (r & 3) + 8 * (r >> 2) + 4 * hi; }
__device__ __forceinline__ unsigned cvtpk(float lo, float hi) { unsigned r; asm volatile("v_cvt_pk_bf16_f32 %0, %1, %2" : "=v"(r) : "v"(lo), "v"(hi)); return r; }
__device__ __forceinline__ void mask_tile(f32x16& p0, f32x16& p1, int dq, unsigned W) {
    const float NEG = -__builtin_inff();
#pragma unroll
    for (int r = 0; r < 16; ++r) {
        const int c = (r & 3) + 8 * (r >> 2);
        if ((unsigned)(dq - c) >= W) p0[r] = NEG;
        if ((unsigned)(dq - c - 32) >= W) p1[r] = NEG;
    }
}
__device__ __forceinline__ void partialSM(f32x16& p0, f32x16& p1, float& m_reg, float& mn, float& alpha) {
    float pmax = p0[0];
#pragma unroll
    for (int r = 1; r < 16; ++r) pmax = fmaxf(pmax, p0[r]);
#pragma unroll
    for (int r = 0; r < 16; ++r) pmax = fmaxf(pmax, p1[r]);
    { auto rr = __builtin_amdgcn_permlane32_swap(__float_as_uint(pmax), __float_as_uint(pmax), false, false);
      pmax = fmaxf(__uint_as_float(rr[0]), __uint_as_float(rr[1])); }
    if (__builtin_expect(__all((pmax - m_reg) * SCALE <= THR), 1)) { mn = m_reg; alpha = 1.f; }
    else { mn = fmaxf(m_reg, pmax); alpha = __builtin_amdgcn_exp2f((m_reg - mn) * C2); m_reg = mn; }
    const float mnL = -mn * C2;
#pragma unroll
    for (int r = 0; r < 16; ++r) p0[r] = fmaf(p0[r], C2, mnL);
#pragma unroll
    for (int r = 0; r < 16; ++r) p1[r] = fmaf(p1[r], C2, mnL);
#pragma unroll
    for (int r = 0; r < 16; ++r) p0[r] = __builtin_amdgcn_exp2f(p0[r]);
}
__device__ __forceinline__ void finishSM(f32x16& p0, f32x16& p1, float alpha, float& l_reg, bf16x8& pa0, bf16x8& pa1, bf16x8& pa2, bf16x8& pa3) {
#pragma unroll
    for (int r = 0; r < 16; ++r) p1[r] = __builtin_amdgcn_exp2f(p1[r]);
    float ps = 0;
#pragma unroll
    for (int r = 0; r < 16; ++r) ps += p0[r];
#pragma unroll
    for (int r = 0; r < 16; ++r) ps += p1[r];
    { auto rr = __builtin_amdgcn_permlane32_swap(__float_as_uint(ps), __float_as_uint(ps), false, false);
      ps = __uint_as_float(rr[0]) + __uint_as_float(rr[1]); }
    l_reg = l_reg * alpha + ps;
#define PK4(P, B_, OUT) do { unsigned a0 = cvtpk(P[B_+0], P[B_+1]), a1 = cvtpk(P[B_+2], P[B_+3]);                          \
        unsigned b0 = cvtpk(P[B_+4], P[B_+5]), b1 = cvtpk(P[B_+6], P[B_+7]);                                             \
        auto r0 = __builtin_amdgcn_permlane32_swap(a0, b0, false, false); auto r1 = __builtin_amdgcn_permlane32_swap(a1, b1, false, false); \
        u32x4 w = {r0[0], r1[0], r0[1], r1[1]}; OUT = *reinterpret_cast<bf16x8*>(&w); } while (0)
    PK4(p0, 0, pa0); PK4(p0, 8, pa1); PK4(p1, 0, pa2); PK4(p1, 8, pa3);
#undef PK4
}
#define ALAS __attribute__((address_space(3)))
__device__ __forceinline__ void qkt(f32x16& p0, f32x16& p1, const ALAS char* Kb, int r32, int hi, const bf16x8* qr) {
    const ALAS char* kb[4];
#pragma unroll
    for (int dd = 0; dd < 4; ++dd) kb[dd] = Kb + KSWZ(r32, (dd * 16 + hi * 8) * 2);
#pragma unroll
    for (int d0 = 0; d0 < 8; ++d0) { const ALAS char* a = kb[d0 & 3] + (d0 >> 2) * 128;
        bf16x8 b0 = *reinterpret_cast<const ALAS bf16x8*>(a);
        bf16x8 b1 = *reinterpret_cast<const ALAS bf16x8*>(a + 32 * 256);
        p0 = __builtin_amdgcn_mfma_f32_32x32x16_bf16(b0, qr[d0], p0, 0, 0, 0);
        p1 = __builtin_amdgcn_mfma_f32_32x32x16_bf16(b1, qr[d0], p1, 0, 0, 0); }
}
__device__ __forceinline__ void pv_tile(f32x16* o, int vb, bf16x8 pa0, bf16x8 pa1, bf16x8 pa2, bf16x8 pa3) {
#define TRRD(dst, off) asm volatile("ds_read_b64_tr_b16 %0, %1 offset:%2" : "=&v"(dst) : "v"(vb), "i"(off) : "memory")
#define PV_D0(d0) do { s16x4 l0, l1, l2, l3, h0, h1, h2, h3; constexpr int b_ = v_rd_off(d0, 0, 0); \
        TRRD(l0, b_); TRRD(h0, b_ + 2048); TRRD(l1, b_ + 4096); TRRD(h1, b_ + 6144); TRRD(l2, b_ + 8192); TRRD(h2, b_ + 10240); TRRD(l3, b_ + 12288); TRRD(h3, b_ + 14336); \
        asm volatile("s_waitcnt lgkmcnt(0)" ::: "memory"); SBAR();   \
        o[d0] = __builtin_amdgcn_mfma_f32_32x32x16_bf16(pa0, (bf16x8){l0[0], l0[1], l0[2], l0[3], h0[0], h0[1], h0[2], h0[3]}, o[d0], 0, 0, 0);   \
        o[d0] = __builtin_amdgcn_mfma_f32_32x32x16_bf16(pa1, (bf16x8){l1[0], l1[1], l1[2], l1[3], h1[0], h1[1], h1[2], h1[3]}, o[d0], 0, 0, 0);   \
        o[d0] = __builtin_amdgcn_mfma_f32_32x32x16_bf16(pa2, (bf16x8){l2[0], l2[1], l2[2], l2[3], h2[0], h2[1], h2[2], h2[3]}, o[d0], 0, 0, 0);   \
        o[d0] = __builtin_amdgcn_mfma_f32_32x32x16_bf16(pa3, (bf16x8){l3[0], l3[1], l3[2], l3[3], h3[0], h3[1], h3[2], h3[3]}, o[d0], 0, 0, 0); } while (0)
    PV_D0(0); PV_D0(1); PV_D0(2); PV_D0(3);
#undef PV_D0
#undef TRRD
}

struct UnitD {
    const bf16* Q; const bf16* K; const bf16* V; int pitch;
    bf16* O; int opitch;
    float* den; float* mx; int spitch;
    const float* lf;
    const float* rel; int head; int dil;
    int q0, jlo, jhi; int W;
    float skip_thr;
};

template <bool FOX>
__device__ __forceinline__ void attn_unit(const UnitD& U, ALAS char* lds, unsigned* qctr, unsigned& nxt_id) {
    int tid_ = threadIdx.x; asm volatile("" : "+v"(tid_));
    const int tid = tid_, wid = __builtin_amdgcn_readfirstlane(tid >> 6), lane = tid & 63, r32 = lane & 31, hi = lane >> 5;
    constexpr bool fox = FOX;
    int NT = U.jhi - U.jlo;
    const int qlo = U.q0 + wid * QBLK, qm = qlo + r32 - 4 * hi;
    const int W = U.W;
    ALAS char* K_lds = lds + L_K; ALAS char* V_lds = lds + L_V;
    ALAS float* wsl = (ALAS float*)(lds + L_WS) + wid * 64; ALAS float* li_l = wsl; ALAS float* al_l = wsl + 32;
    ALAS float* cbl = (ALAS float*)(lds + L_CB); ALAS float* Tl = (ALAS float*)(lds + L_TB);
    const int vb0 = (int)(unsigned)(uintptr_t)V_lds + v_rd_base(lane);
    int koff[2], voff[2];
#pragma unroll
    for (int i = 0; i < 2; ++i) {
        const int L = (wid * 2 + i) * 64 + lane;
        { const int r = L >> 4, c = (L & 15) ^ (r & 7); koff[i] = r * U.pitch + c * 8; }
        { const int o = L * 16, sub = o >> 9, kkhi = sub >> 2, cblk = sub & 3, w16 = (o & 511) >> 1, kk = kkhi * 8 + (w16 >> 5), cc = cblk * 32 + (w16 & 31);
          const int k = (kk & ~0xC) | ((kk & 4) << 1) | ((kk & 8) >> 1); voff[i] = k * U.pitch + cc; }
    }
#define DMA_K(kb_, buf_) do { const bf16* kg_ = U.K + (size_t)(kb_) * U.pitch;                                                              \
        _Pragma("unroll") for (int i_ = 0; i_ < 2; ++i_)                                                                                 \
            __builtin_amdgcn_global_load_lds((const unsigned*)(kg_ + koff[i_]), (ALAS unsigned*)(K_lds + (buf_) * SHM_K + (wid * 2 + i_) * 1024), 16, 0, 0); } while (0)
#define DMA_V(kb_, buf_) do { const bf16* vg_ = U.V + (size_t)(kb_) * U.pitch;                                                              \
        _Pragma("unroll") for (int i_ = 0; i_ < 2; ++i_)                                                                                 \
            __builtin_amdgcn_global_load_lds((const unsigned*)(vg_ + voff[i_]), (ALAS unsigned*)(V_lds + (buf_) * SHM_V + (wid * 2 + i_) * 1024), 16, 0, 0); } while (0)
#define KB_(it_) ((U.jhi - 1 - (it_)) * KVBLK)
    bf16x8 qr[8];
    { const bf16* qp = U.Q + (size_t)(qlo + r32) * U.pitch + hi * 8;
#pragma unroll
      for (int d0 = 0; d0 < 8; ++d0) qr[d0] = *(const bf16x8*)(qp + d0 * 16); }
    DMA_K(KB_(0), 0); DMA_V(KB_(0), 0);
    if (NT > 1) DMA_K(KB_(1), 1);
    float cqs = 0.f;
    const int s0 = U.jlo * KVBLK;
    if (fox) {
        const int n = U.q0 + QB - s0, t0 = tid * 8; float v[8]; float s8 = 0.f;
        if (t0 < n) { const f32x4 a0 = *(const f32x4*)(U.lf + s0 + t0), a1 = *(const f32x4*)(U.lf + s0 + t0 + 4);
            v[0] = a0[0]; v[1] = a0[1]; v[2] = a0[2]; v[3] = a0[3]; v[4] = a1[0]; v[5] = a1[1]; v[6] = a1[2]; v[7] = a1[3]; }
        else {
#pragma unroll
            for (int i = 0; i < 8; ++i) v[i] = 0.f; }
#pragma unroll
        for (int i = 0; i < 8; ++i) s8 += v[i];
        float incl = s8;
#pragma unroll
        for (int o = 1; o < 64; o <<= 1) { const float t = __shfl_up(incl, o); if (lane >= o) incl += t; }
        ALAS float* wtot = (ALAS float*)(lds + L_WT);
        if (lane == 63) wtot[wid] = incl;
        __syncthreads();
        float run = incl - s8;
        for (int w = 0; w < wid; ++w) run += wtot[w];
        if (t0 < n) {
#pragma unroll
            for (int i = 0; i < 8; ++i) { run += v[i]; cbl[t0 + i] = -run * INV_SCALE; } }
    } else {
        if (tid < TB_N) Tl[tid] = U.rel[tid];
    }
    float m_reg = -1e30f, l_reg = 0.f; f32x16 o[4];
#pragma unroll
    for (int d = 0; d < 4; ++d)
#pragma unroll
        for (int r = 0; r < 16; ++r) o[d][r] = 0.f;
    asm volatile("s_waitcnt vmcnt(0)" ::: "memory");
    __syncthreads();
    if (fox) {
        cqs = -cbl[qlo + r32 - s0];
        bool ns = false;
        if (lane < NT) { const int kbt = (U.jhi - 1 - lane) * KVBLK; ns = (kbt + KVBLK - 1 >= U.q0) || (cbl[kbt + KVBLK - 1 - s0] - cbl[U.q0 - s0] >= U.skip_thr); }
        const unsigned long long mk = __ballot(ns);
        NT = __builtin_amdgcn_readfirstlane(64 - __builtin_clzll(mk | 1ull));
    }
#define ACT_(kb_) (FOX || ((kb_) <= qlo + QBLK - 1 && (kb_) + KVBLK - 1 >= qlo - W + 1))
#define QK(P0_, P1_, it_, buf_) do { const int kb_ = KB_(it_);                                                                           \
        if (ACT_(kb_)) {                                                                                                                \
            if (fox) { const ALAS float* ck_ = cbl + (kb_ - s0) + 4 * hi;                                                                      \
                _Pragma("unroll") for (int g = 0; g < 4; ++g) { const f32x4 a_ = *(const ALAS f32x4*)(ck_ + 8 * g), b_ = *(const ALAS f32x4*)(ck_ + 32 + 8 * g);   \
                    _Pragma("unroll") for (int e = 0; e < 4; ++e) { P0_[4 * g + e] = cqs + a_[e]; P1_[4 * g + e] = cqs + b_[e]; } } }   \
            else { const ALAS float* tb_ = Tl + (TB_PAD - 59) + (qm - kb_);                                                             \
                _Pragma("unroll") for (int r = 0; r < 16; ++r) { const int c_ = (r & 3) + 8 * (r >> 2); P0_[r] = tb_[59 - c_]; P1_[r] = tb_[27 - c_]; } }  \
            qkt(P0_, P1_, K_lds + (buf_) * SHM_K, r32, hi, qr);                                                                         \
        } else { const float NEG_ = -__builtin_inff(); _Pragma("unroll") for (int r = 0; r < 16; ++r) { P0_[r] = NEG_; P1_[r] = NEG_; } } } while (0)
#define MASKT(P0_, P1_, it_) do { const int kb_ = KB_(it_);                                                                              \
        if (ACT_(kb_) && (kb_ + KVBLK - 1 > qlo || kb_ <= qlo + QBLK - 1 - W)) mask_tile(P0_, P1_, qm - kb_, (unsigned)W); } while (0)
#define PV(it_, buf_) do { if (ACT_(KB_(it_))) pv_tile(o, vb0 + (buf_) * SHM_V, pa0, pa1, pa2, pa3); } while (0)
#define RESC(a_) do { if (__any((a_) < 1.f)) { if (hi == 0) al_l[r32] = (a_); asm volatile("s_waitcnt lgkmcnt(0)" ::: "memory"); const ALAS float* alh_ = al_l + 4 * hi;  \
        _Pragma("unroll") for (int d_ = 0; d_ < 4; ++d_) _Pragma("unroll") for (int r = 0; r < 16; ++r) o[d_][r] *= alh_[(r & 3) + 8 * (r >> 2)]; } } while (0)
#ifdef PROBE_ATT
    const unsigned long long tl0_ = __builtin_amdgcn_s_memrealtime();
#endif
    f32x16 pA0, pA1, pB0, pB1; float mnA, mnB, alA, alB; bf16x8 pa0, pa1, pa2, pa3;
#define STEP_END(t_) do { if ((t_) + 2 < NT) asm volatile("s_waitcnt vmcnt(4)" ::: "memory"); else asm volatile("s_waitcnt vmcnt(0)" ::: "memory");   \
        asm volatile("s_waitcnt lgkmcnt(0)" ::: "memory"); __builtin_amdgcn_s_barrier(); asm volatile("" ::: "memory"); } while (0)
    if (NT > 2) DMA_K(KB_(2), 2);
    if (NT > 1) DMA_V(KB_(1), 1);
    QK(pA0, pA1, 0, 0); MASKT(pA0, pA1, 0); partialSM(pA0, pA1, m_reg, mnA, alA);
    STEP_END(0);
#define HALF(PX0, PX1, mnX, alX, PY0, PY1, alY, t_, bx_, by_, bn_) do {                                                                  \
        if ((t_) + 2 < NT) DMA_K(KB_((t_) + 2), by_);                                                                                  \
        if ((t_) + 1 < NT) DMA_V(KB_((t_) + 1), bn_);                                                                                  \
        SBAR(); QK(PX0, PX1, t_, bx_);                                                                                                  \
        finishSM(PY0, PY1, alY, l_reg, pa0, pa1, pa2, pa3); SBAR();                                                                     \
        PV((t_) - 1, by_); MASKT(PX0, PX1, t_); partialSM(PX0, PX1, m_reg, mnX, alX);                                                   \
        RESC(alX);                                                                                                                      \
        STEP_END(t_); } while (0)
    int t = 1, b0 = 0, b1 = 1, b2 = 2;
    for (; t + 1 < NT; t += 2) {
        HALF(pB0, pB1, mnB, alB, pA0, pA1, alA, t, b1, b0, b2);
        HALF(pA0, pA1, mnA, alA, pB0, pB1, alB, t + 1, b2, b1, b0);
        { const int n0 = b2, n1 = b0, n2 = b1; b0 = n0; b1 = n1; b2 = n2; }
    }
    int bl = b0;
    if ((NT & 1) == 0) {
        SBAR(); QK(pB0, pB1, NT - 1, b1);
        finishSM(pA0, pA1, alA, l_reg, pa0, pa1, pa2, pa3); SBAR();
        PV(NT - 2, b0); MASKT(pB0, pB1, NT - 1); partialSM(pB0, pB1, m_reg, mnB, alB);
        RESC(alB);
        pA0 = pB0; pA1 = pB1; alA = alB; bl = b1;
    }
    finishSM(pA0, pA1, alA, l_reg, pa0, pa1, pa2, pa3); SBAR();
    PV(NT - 1, bl);
#undef HALF
#undef RESC
#undef PV
#undef MASKT
#undef QK
#undef ACT_
#undef KB_
#undef DMA_K
#undef DMA_V
#undef STEP_END
#ifdef PROBE_ATT
    if (tid == 0) *(volatile ALAS unsigned*)(lds + 131072 + 8192 + 68) += (unsigned)(__builtin_amdgcn_s_memrealtime() - tl0_);
#endif
    if (tid == 0) nxt_id = atomicAdd(qctr, 1u);
    if (hi == 0) li_l[r32] = l_reg;
    asm volatile("s_waitcnt lgkmcnt(0)" ::: "memory");
    float rli[16];
    { const ALAS float* lih = li_l + 4 * hi;
#pragma unroll
    for (int r = 0; r < 16; ++r) rli[r] = __builtin_amdgcn_rcpf(lih[(r & 3) + 8 * (r >> 2)]); }
    __syncthreads();
    { ALAS float* St = (ALAS float*)(lds + wid * 8192);
      const int rr8 = lane >> 3, c8 = lane & 7;
#pragma unroll
      for (int hf = 0; hf < 2; ++hf) {
#pragma unroll
          for (int r = 0; r < 16; ++r) { const int orow = (r & 3) + 8 * (r >> 2) + 4 * hi;
#pragma unroll
              for (int dd = 0; dd < 2; ++dd) St[orow * 64 + dd * 32 + r32] = o[hf * 2 + dd][r] * rli[r]; }
          asm volatile("s_waitcnt lgkmcnt(0)" ::: "memory");
          bf16* Ow = U.O + (size_t)qlo * U.opitch + hf * 64 + c8 * 8;
#pragma unroll
          for (int j = 0; j < 4; ++j) { const int row = 8 * j + rr8;
              const f32x4 a0 = *(const ALAS f32x4*)(St + row * 64 + c8 * 8), a1 = *(const ALAS f32x4*)(St + row * 64 + c8 * 8 + 4);
              u32x4 w = {cvtpk(a0[0], a0[1]), cvtpk(a0[2], a0[3]), cvtpk(a1[0], a1[1]), cvtpk(a1[2], a1[3])};
              *(u32x4*)(Ow + (size_t)row * U.opitch) = w; }
          asm volatile("s_waitcnt lgkmcnt(0)" ::: "memory");
      } }
    if (U.den != nullptr && hi == 0) { U.den[(size_t)(qlo + r32) * U.spitch] = l_reg; U.mx[(size_t)(qlo + r32) * U.spitch] = m_reg; }
}

constexpr int D_WS = 131072, D_TB = D_WS + NW * 64 * 4;
__device__ __forceinline__ void attn_unit_dil(const UnitD& U, ALAS char* lds, unsigned* qctr, unsigned& nxt_id) {
    int tid_ = threadIdx.x; asm volatile("" : "+v"(tid_));
    const int tid = tid_, wid = __builtin_amdgcn_readfirstlane(tid >> 6), lane = tid & 63, r32 = lane & 31, hi = lane >> 5;
    const int qlo = U.q0 + wid * QBLK, qm = qlo + r32 - 4 * hi;
    const int NT = (qlo >> 5) + 1 < 5 ? (qlo >> 5) + 1 : 5;
    ALAS char* Kb = lds + wid * 16384; ALAS char* Vb = Kb + 8192;
    ALAS float* wsl = (ALAS float*)(lds + D_WS) + wid * 64; ALAS float* li_l = wsl; ALAS float* al_l = wsl + 32;
    ALAS float* Tl = (ALAS float*)(lds + D_TB);
    const int vb = (int)(unsigned)(uintptr_t)Vb + v_rd_base(lane);
    const int g4 = lane >> 4, c16 = lane & 15;
    const int koffE = g4 * U.pitch + ((c16 ^ g4) << 3), koffO = g4 * U.pitch + ((c16 ^ (4 + g4)) << 3);
    const int kklo = (lane & 31) >> 2, voffL = (8 * (kklo >> 2) + (kklo & 3)) * U.pitch + (lane >> 5) * 32 + ((lane & 3) << 3);
#define DMA_K32(kb_) do { const bf16* kg_ = U.K + (size_t)(kb_) * U.pitch;                                                                  \
        _Pragma("unroll") for (int i_ = 0; i_ < 8; ++i_)                                                                                  \
            __builtin_amdgcn_global_load_lds((const unsigned*)(kg_ + (size_t)(4 * i_) * U.pitch + ((i_ & 1) ? koffO : koffE)), (ALAS unsigned*)(Kb + i_ * 1024), 16, 0, 0); } while (0)
#define DMA_V32(kb_) do { const bf16* vg_ = U.V + (size_t)(kb_) * U.pitch;                                                                  \
        _Pragma("unroll") for (int i_ = 0; i_ < 8; ++i_)                                                                                  \
            __builtin_amdgcn_global_load_lds((const unsigned*)(vg_ + (size_t)(16 * (i_ >> 2) + 4 * ((i_ >> 1) & 1)) * U.pitch + 64 * (i_ & 1) + voffL), (ALAS unsigned*)(Vb + i_ * 1024), 16, 0, 0); } while (0)
    bf16x8 qr[8];
    { const bf16* qp = U.Q + (size_t)(qlo + r32) * U.pitch + hi * 8;
#pragma unroll
      for (int d0 = 0; d0 < 8; ++d0) qr[d0] = *(const bf16x8*)(qp + d0 * 16); }
    DMA_K32(qlo); DMA_V32(qlo);
    if (tid < TB_N) Tl[tid] = U.rel[tid];
    float m_reg = -1e30f, l_reg = 0.f; f32x16 o[4];
#pragma unroll
    for (int d = 0; d < 4; ++d)
#pragma unroll
        for (int r = 0; r < 16; ++r) o[d][r] = 0.f;
    asm volatile("s_waitcnt vmcnt(0)" ::: "memory");
    __syncthreads();
    for (int t = 0; t < NT; ++t) {
        const int kb = qlo - 32 * t; const bool more = t + 1 < NT;
        f32x16 p0;
        { const ALAS float* tb_ = Tl + (TB_PAD - 59) + (qm - kb);
#pragma unroll
          for (int r = 0; r < 16; ++r) { const int c_ = (r & 3) + 8 * (r >> 2); p0[r] = tb_[59 - c_]; } }
        { const ALAS char* kbp[4];
#pragma unroll
          for (int dd = 0; dd < 4; ++dd) kbp[dd] = Kb + KSWZ(r32, (dd * 16 + hi * 8) * 2);
#pragma unroll
          for (int d0 = 0; d0 < 8; ++d0) { const bf16x8 b0 = *reinterpret_cast<const ALAS bf16x8*>(kbp[d0 & 3] + (d0 >> 2) * 128);
              p0 = __builtin_amdgcn_mfma_f32_32x32x16_bf16(b0, qr[d0], p0, 0, 0, 0); } }
        asm volatile("" ::: "memory"); SBAR();
        if (more) DMA_K32(kb - 32);
        SBAR();
        if (t == 0 || kb == qlo - 128) { const float NEG = -__builtin_inff(); const int dq = qm - kb;
#pragma unroll
            for (int r = 0; r < 16; ++r) { const int c = (r & 3) + 8 * (r >> 2); if ((unsigned)(dq - c) >= 129u) p0[r] = NEG; } }
        float pmax = p0[0];
#pragma unroll
        for (int r = 1; r < 16; ++r) pmax = fmaxf(pmax, p0[r]);
        { auto rr = __builtin_amdgcn_permlane32_swap(__float_as_uint(pmax), __float_as_uint(pmax), false, false);
          pmax = fmaxf(__uint_as_float(rr[0]), __uint_as_float(rr[1])); }
        float mn, alpha;
        if (__builtin_expect(__all((pmax - m_reg) * SCALE <= THR), 1)) { mn = m_reg; alpha = 1.f; }
        else { mn = fmaxf(m_reg, pmax); alpha = __builtin_amdgcn_exp2f((m_reg - mn) * C2); m_reg = mn; }
        const float mnL = -mn * C2; float ps = 0.f;
#pragma unroll
        for (int r = 0; r < 16; ++r) { p0[r] = __builtin_amdgcn_exp2f(fmaf(p0[r], C2, mnL)); ps += p0[r]; }
        { auto rr = __builtin_amdgcn_permlane32_swap(__float_as_uint(ps), __float_as_uint(ps), false, false);
          ps = __uint_as_float(rr[0]) + __uint_as_float(rr[1]); }
        l_reg = l_reg * alpha + ps;
        if (__any(alpha < 1.f)) { if (hi == 0) al_l[r32] = alpha; asm volatile("s_waitcnt lgkmcnt(0)" ::: "memory"); const ALAS float* alh_ = al_l + 4 * hi;
#pragma unroll
            for (int d_ = 0; d_ < 4; ++d_)
#pragma unroll
                for (int r = 0; r < 16; ++r) o[d_][r] *= alh_[(r & 3) + 8 * (r >> 2)]; }
        bf16x8 pa0, pa1;
#define PK4(P, B_, OUT) do { unsigned a0 = cvtpk(P[B_+0], P[B_+1]), a1 = cvtpk(P[B_+2], P[B_+3]);                          \
        unsigned b0 = cvtpk(P[B_+4], P[B_+5]), b1 = cvtpk(P[B_+6], P[B_+7]);                                             \
        auto r0 = __builtin_amdgcn_permlane32_swap(a0, b0, false, false); auto r1 = __builtin_amdgcn_permlane32_swap(a1, b1, false, false); \
        u32x4 w = {r0[0], r1[0], r0[1], r1[1]}; OUT = *reinterpret_cast<bf16x8*>(&w); } while (0)
        PK4(p0, 0, pa0); PK4(p0, 8, pa1);
#undef PK4
        if (more) asm volatile("s_waitcnt vmcnt(8)" ::: "memory"); else asm volatile("s_waitcnt vmcnt(0)" ::: "memory");
        SBAR();
#define TRRD(dst, off) asm volatile("ds_read_b64_tr_b16 %0, %1 offset:%2" : "=&v"(dst) : "v"(vb), "i"(off) : "memory")
#define PV_D0(d0) do { s16x4 l0, l1, h0, h1; constexpr int b_ = v_rd_off(d0, 0, 0); TRRD(l0, b_); TRRD(h0, b_ + 2048); TRRD(l1, b_ + 4096); TRRD(h1, b_ + 6144); \
        asm volatile("s_waitcnt lgkmcnt(0)" ::: "memory"); SBAR();   \
        o[d0] = __builtin_amdgcn_mfma_f32_32x32x16_bf16(pa0, (bf16x8){l0[0], l0[1], l0[2], l0[3], h0[0], h0[1], h0[2], h0[3]}, o[d0], 0, 0, 0);   \
        o[d0] = __builtin_amdgcn_mfma_f32_32x32x16_bf16(pa1, (bf16x8){l1[0], l1[1], l1[2], l1[3], h1[0], h1[1], h1[2], h1[3]}, o[d0], 0, 0, 0); } while (0)
        PV_D0(0); PV_D0(1); PV_D0(2); PV_D0(3);
#undef PV_D0
#undef TRRD
        asm volatile("" ::: "memory"); SBAR();
        if (more) { DMA_V32(kb - 32);
            asm volatile("s_waitcnt vmcnt(8)" ::: "memory"); SBAR(); }
    }
#undef DMA_K32
#undef DMA_V32
    if (tid == 0) nxt_id = atomicAdd(qctr, 1u);
    if (hi == 0) li_l[r32] = l_reg;
    asm volatile("s_waitcnt lgkmcnt(0)" ::: "memory");
    float rli[16];
    { const ALAS float* lih = li_l + 4 * hi;
#pragma unroll
    for (int r = 0; r < 16; ++r) rli[r] = __builtin_amdgcn_rcpf(lih[(r & 3) + 8 * (r >> 2)]); }
    { ALAS float* St = (ALAS float*)Kb;
#pragma unroll
      for (int r = 0; r < 16; ++r) { const int orow = (r & 3) + 8 * (r >> 2) + 4 * hi;
#pragma unroll
          for (int d0 = 0; d0 < 4; ++d0) St[orow * 128 + d0 * 32 + r32] = o[d0][r] * rli[r]; }
      asm volatile("s_waitcnt lgkmcnt(0)" ::: "memory");
      bf16* Ow = U.O + (size_t)qlo * U.opitch + c16 * 8;
#pragma unroll
      for (int j = 0; j < 8; ++j) { const int row = 4 * j + g4;
          const f32x4 a0 = *(const ALAS f32x4*)(St + row * 128 + c16 * 8), a1 = *(const ALAS f32x4*)(St + row * 128 + c16 * 8 + 4);
          u32x4 w = {cvtpk(a0[0], a0[1]), cvtpk(a0[2], a0[3]), cvtpk(a1[0], a1[1]), cvtpk(a1[2], a1[3])};
          *(u32x4*)(Ow + (size_t)row * U.opitch) = w; } }
    if (hi == 0) { U.den[(size_t)(qlo + r32) * U.spitch] = l_reg; U.mx[(size_t)(qlo + r32) * U.spitch] = m_reg; }
}
}

#define GAS __attribute__((address_space(1)))
#define LAS __attribute__((address_space(3)))
#define XB_TMO      128
#define XB_XCNT(j)  (256  + 64 * (j))
#define XB_XSUB(j)  (1280 + 64 * (j))
#define XB_XGEN(j)  (2304 + 64 * (j))
#define XB_TOP      3328
#define XB_TOPGEN   3392
#define XCD_BAR_WORDS 3456
#define XB_SPIN_CAP (1u << 18)

__device__ __forceinline__ unsigned xb_ld(unsigned* p)              { return __hip_atomic_load(p, __ATOMIC_RELAXED, __HIP_MEMORY_SCOPE_AGENT); }
__device__ __forceinline__ unsigned xb_add(unsigned* p, unsigned v) { return __hip_atomic_fetch_add(p, v, __ATOMIC_RELAXED, __HIP_MEMORY_SCOPE_AGENT); }
__device__ __forceinline__ unsigned xb_xcc_id() { return (unsigned)__builtin_amdgcn_s_getreg((3 << 11) | 20) & 0xFu; }
#define XB_SPIN(cond, bar) do { unsigned _sp = 0; while (cond) { __builtin_amdgcn_s_sleep(1); \
    if ((++_sp & 255u) == 0u) { if (xb_ld(&(bar)[XB_TMO])) break; if (_sp > XB_SPIN_CAP) { atomicAdd(&(bar)[XB_TMO], 1u); break; } } } } while (0)

struct XcdBarrier {
    unsigned* bar; unsigned x;
    volatile LAS unsigned* st;
};

__device__ __forceinline__ XcdBarrier xcd_barrier_post(unsigned* bar, volatile LAS unsigned* st) {
    XcdBarrier b; b.bar = bar; b.x = xb_xcc_id(); b.st = st;
    if (threadIdx.x == 0) (void)xb_add(&bar[XB_XCNT(b.x)], 1u);
    return b;
}
__device__ __forceinline__ void xcd_barrier_complete(unsigned* bar, unsigned x, unsigned& nloc, unsigned& nx) {
    const unsigned G = gridDim.x * gridDim.y * gridDim.z;
    unsigned sum, cnt, mine, sp = 0u;
    for (;;) {
        sum = 0u; cnt = 0u; mine = 0u;
#pragma unroll
        for (unsigned j = 0; j < 16; ++j) { const unsigned c = xb_ld(&bar[XB_XCNT(j)]); sum += c; cnt += (c > 0u) ? 1u : 0u; mine = (j == x) ? c : mine; }
        if (sum == G) break;
        __builtin_amdgcn_s_sleep(1);
        if ((++sp & 255u) == 0u) { if (xb_ld(&bar[XB_TMO])) break; if (sp > XB_SPIN_CAP) { atomicAdd(&bar[XB_TMO], 1u); break; } }
    }
    nloc = mine > 0u ? mine : 1u; nx = cnt > 0u ? cnt : 1u;
}

__device__ __forceinline__ void xcd_barrier(const XcdBarrier& b) {
    asm volatile("s_waitcnt vmcnt(0)" ::: "memory");
    __syncthreads();
    if (threadIdx.x == 0) {
        unsigned* bar = b.bar;
        __builtin_amdgcn_s_waitcnt(0);
        unsigned nloc = b.st[0], nx = b.st[1];
        if (nloc == 0u) { xcd_barrier_complete(bar, b.x, nloc, nx); b.st[0] = nloc; b.st[1] = nx; }
        const unsigned old = xb_add(&bar[XB_XSUB(b.x)], 1u);
        const unsigned gen = old / nloc;
        if (old + 1u == (gen + 1u) * nloc) {
            __builtin_amdgcn_fence(__ATOMIC_RELEASE, "agent");
            asm volatile("s_waitcnt vmcnt(0)" ::: "memory");
            const unsigned og = xb_add(&bar[XB_TOP], 1u);
            const unsigned tg = og / nx;
            if (og + 1u == (tg + 1u) * nx) xb_add(&bar[XB_TOPGEN], 1u);
            else XB_SPIN(xb_ld(&bar[XB_TOPGEN]) == tg, bar);
            __builtin_amdgcn_fence(__ATOMIC_ACQUIRE, "agent");
            xb_add(&bar[XB_XGEN(b.x)], 1u);
            asm volatile("s_waitcnt vmcnt(0)" ::: "memory");
        } else {
            XB_SPIN(xb_ld(&bar[XB_XGEN(b.x)]) == gen, bar);
            __builtin_amdgcn_fence(__ATOMIC_ACQUIRE, "agent");
            asm volatile("s_waitcnt vmcnt(0)" ::: "memory");
        }
    }
    __syncthreads();
}


constexpr int BATCH = 2, SEQ = 4096, DM = 2048, MROWS = BATCH * SEQ, DFF = 5504, HD = 128, HA = 8, HB = 8, DPROJ = 6152, NQKV = 6144;
constexpr float RMS_EPS = 1e-6f;
constexpr int NWAVES = 8, NTHREADS = 512;
constexpr int LDS_BYTES = 151552;
constexpr int RING_BYTES = 131072, XCH_OFF = RING_BYTES, MISC_OFF = XCH_OFF + 8192, RS_OFF = MISC_OFF + 128, GN_OFF = RS_OFF + 6 * 256 * 4;
static_assert(GN_OFF + 512 * 4 <= LDS_BYTES, "LDS map");
typedef unsigned short bf16;
typedef float f32x4 __attribute__((ext_vector_type(4)));
typedef unsigned u32x4v __attribute__((ext_vector_type(4)));
typedef unsigned u32x2v __attribute__((ext_vector_type(2)));
typedef float f32x2v __attribute__((ext_vector_type(2)));

constexpr size_t MiB = 1u << 20;
constexpr size_t WS_CTL = 0; constexpr int CW_BAR = 4096; constexpr size_t CTL_ZERO_BYTES = 64 * 1024;
constexpr size_t WS_WF = 64 * 1024;
constexpr size_t WS_LOGF = 128 * 1024;
constexpr size_t WS_PSS = 384 * 1024;
constexpr size_t WS_STAT = 640 * 1024;
constexpr size_t WS_TBL = 3712 * 1024;
constexpr size_t WS_FSTAT = 2304 * 1024;
constexpr size_t WS_W1I = 4 * MiB;
constexpr size_t WS_W1O = WS_W1I + 43 * MiB;
constexpr size_t WS_WIN = WS_W1O + 22 * MiB;
constexpr size_t WS_WOUT = WS_WIN + 24 * MiB;
constexpr size_t WS_W2I = WS_WOUT + 8 * MiB;
constexpr size_t WS_W2O = WS_W2I + 43 * MiB;
constexpr size_t WS_H = WS_W2O + 22 * MiB;
constexpr size_t WS_ACT = WS_H + 32 * MiB;
constexpr size_t WS_OPART = WS_ACT + 96 * MiB;
constexpr size_t WS_END = WS_OPART + 48 * MiB;

struct Args {
    const float* x; const float* n1; const float* w1i; const float* w1o; const float* nmix; const float* win;
    const float* gains[4]; const float* fbias; const float* rel; const float* wout; const float* n2; const float* w2i; const float* w2o;
    float* out; unsigned char* ws; int ph_lo, ph_hi;
};

__device__ __forceinline__ float wave_sum(float v) {
#pragma unroll
    for (int o = 1; o < 64; o <<= 1) v += __shfl_xor(v, o);
    return v;
}
__device__ __forceinline__ unsigned f2bf(float f) { unsigned u = __builtin_bit_cast(unsigned, f); return (u + 0x7fffu + ((u >> 16) & 1u)) >> 16; }
__device__ __forceinline__ unsigned pk2(float lo, float hi) { return f2bf(lo) | (f2bf(hi) << 16); }

struct ConvTab { const float* src[6]; bf16* dst[6]; };
constexpr int CV_I0 = (DM / 64) * (2 * DFF / 64), CV_I1 = (DFF / 64) * (DM / 64), CV_I2 = (DM / 64) * (NQKV / 64), CV_I3 = (DM / 64) * (DM / 64);
constexpr int CV_E0 = CV_I0, CV_E1 = CV_E0 + CV_I1, CV_E2 = CV_E1 + CV_I2, CV_E3 = CV_E2 + CV_I3, CV_E4 = CV_E3 + CV_I0, CV_E5 = CV_E4 + CV_I1;
__device__ __forceinline__ void conv_decode(int it, const float* w1i, const float* w1o, const float* win, const float* wout, const float* w2i, const float* w2o,
                                            bf16* W1I, bf16* W1O, bf16* WIN, bf16* WOUT, bf16* W2I, bf16* W2O, const float* g1, const float* gmix, const float* g2, const float*& src, bf16*& dst, int& ldw, int& K, const float*& gk) {
    int r = it; const float* W; bf16* WT; int nblk, kind; const float* gv = nullptr;
    if (r < CV_E0) { W = w1i; WT = W1I; K = DM; ldw = 2 * DFF; nblk = 2 * DFF / 64; kind = 1; gv = g1; }
    else if (r < CV_E1) { r -= CV_E0; W = w1o; WT = W1O; K = DFF; ldw = DM; nblk = DM / 64; kind = 0; }
    else if (r < CV_E2) { r -= CV_E1; W = win; WT = WIN; K = DM; ldw = DPROJ; nblk = NQKV / 64; kind = 0; gv = gmix; }
    else if (r < CV_E3) { r -= CV_E2; W = wout; WT = WOUT; K = DM; ldw = DM; nblk = DM / 64; kind = 0; }
    else if (r < CV_E4) { r -= CV_E3; W = w2i; WT = W2I; K = DM; ldw = 2 * DFF; nblk = 2 * DFF / 64; kind = 1; gv = g2; }
    else { r -= CV_E4; W = w2o; WT = W2O; K = DFF; ldw = DM; nblk = DM / 64; kind = 0; }
    const int kb = r / nblk, nb = r - kb * nblk, n0 = nb * 64;
    int drow = n0;
    if (kind == 1) { const int half = n0 / DFF, jj = n0 - half * DFF; drow = (jj >> 7) * 256 + half * 128 + (jj & 127); }
    src = W + (size_t)(kb * 64) * ldw + n0; dst = WT + (size_t)drow * K + kb * 64; gk = gv ? gv + kb * 64 : nullptr;
}
__device__ __forceinline__ unsigned cvtpk_bf16(float lo, float hi) { unsigned r; asm volatile("v_cvt_pk_bf16_f32 %0, %1, %2" : "=v"(r) : "v"(lo), "v"(hi)); return r; }
#define FILL_RS(S_) do { LAS float* rs_ = (LAS float*)(ldsl + RS_OFF); pg8::Unit u_; int pm_[6]; int nu_ = 0;                               \
        _Pragma("unroll") for (int i_ = 0; i_ < 6; ++i_) { pm_[i_] = 0; if ((S_).next(i_, u_)) { pm_[i_] = u_.pm; nu_ = i_ + 1; } }          \
        _Pragma("unroll") for (int r_ = 0; r_ < 3; ++r_) { const int idx_ = tid + r_ * NTHREADS, ui_ = idx_ >> 8;                           \
            if (ui_ < nu_) { const int pmv_ = (ui_ == 0) ? pm_[0] : (ui_ == 1) ? pm_[1] : (ui_ == 2) ? pm_[2] : (ui_ == 3) ? pm_[3] : (ui_ == 4) ? pm_[4] : pm_[5]; \
                const float* pp_ = PSS + (size_t)(pmv_ * 256 + (idx_ & 255)) * 8;                                                         \
                const f32x4 p0_ = *(const f32x4*)pp_, p1_ = *(const f32x4*)(pp_ + 4);                                                    \
                rs_[idx_] = 1.0f / sqrtf((((p0_[0] + p0_[1]) + (p0_[2] + p0_[3])) + ((p1_[0] + p1_[1]) + (p1_[2] + p1_[3]))) * (1.0f / DM) + RMS_EPS); } } \
        __syncthreads(); } while (0)
#define CONV_ARGS a.w1i, a.w1o, a.win, a.wout, a.w2i, a.w2o, W1I, W1O, WIN, WOUT, W2I, W2O, a.n1, a.nmix, a.n2
#define CONV_RANGE(lo_, hi_, w_, nw_, T_, NTST_) do {                                                                                           \
        const int l15_ = lane & 15, g_ = lane >> 4; int it_ = (lo_) + (w_);                                                            \
        f32x4 va_[8], vb_[8]; f32x2v ga_[8]; const float* src_; bf16* dst_; int ldw_, K_; const float* gk_;                              \
        if (it_ < (hi_)) { conv_decode(it_, CONV_ARGS, src_, dst_, ldw_, K_, gk_);                                                          \
            const float* p_ = src_ + (size_t)(2 * g_) * ldw_ + 4 * l15_;                                                               \
            _Pragma("unroll") for (int i = 0; i < 8; ++i) { va_[i] = __builtin_nontemporal_load((const f32x4*)(p_ + (size_t)(8 * i) * ldw_)); vb_[i] = __builtin_nontemporal_load((const f32x4*)(p_ + (size_t)(8 * i + 1) * ldw_)); }   \
            _Pragma("unroll") for (int i = 0; i < 8; ++i) ga_[i] = gk_ ? *(const f32x2v*)(gk_ + 8 * i + 2 * g_) : (f32x2v){1.f, 1.f}; }   \
        while (it_ < (hi_)) {                                                                                                           \
            _Pragma("unroll") for (int i = 0; i < 8; ++i) _Pragma("unroll") for (int j = 0; j < 4; ++j)                                 \
                (T_)[(4 * l15_ + j) * 32 + ((i ^ (l15_ & 7)) << 2) + g_] = cvtpk_bf16(va_[i][j] * ga_[i].x, vb_[i][j] * ga_[i].y);                             \
            bf16* dcur_ = dst_; const int Kcur_ = K_; it_ += (nw_);                                                                     \
            if (it_ < (hi_)) { conv_decode(it_, CONV_ARGS, src_, dst_, ldw_, K_, gk_);                                                      \
                const float* p_ = src_ + (size_t)(2 * g_) * ldw_ + 4 * l15_;                                                           \
                _Pragma("unroll") for (int i = 0; i < 8; ++i) { va_[i] = __builtin_nontemporal_load((const f32x4*)(p_ + (size_t)(8 * i) * ldw_)); vb_[i] = __builtin_nontemporal_load((const f32x4*)(p_ + (size_t)(8 * i + 1) * ldw_)); }   \
            _Pragma("unroll") for (int i = 0; i < 8; ++i) ga_[i] = gk_ ? *(const f32x2v*)(gk_ + 8 * i + 2 * g_) : (f32x2v){1.f, 1.f}; }   \
            _Pragma("unroll") for (int s2 = 0; s2 < 8; ++s2) { const int n_ = 8 * s2 + (lane >> 3), c_ = lane & 7;                       \
                const u32x4v wv_ = *(const LAS u32x4v*)((T_) + n_ * 32 + ((c_ ^ ((n_ >> 2) & 7)) << 2));                                 \
                if (NTST_) __builtin_nontemporal_store(wv_, (u32x4v*)(dcur_ + (size_t)n_ * Kcur_ + 8 * c_)); else *(u32x4v*)(dcur_ + (size_t)n_ * Kcur_ + 8 * c_) = wv_; }                                                                \
        } } while (0)

__device__ __forceinline__ void norm_row(const float* xrow, const float* g, bf16* orow, int lane, const float* wf, const float* fbias, float* logf_row) {
    const f32x4* xr = (const f32x4*)xrow + lane; const f32x4* gr = (const f32x4*)g + lane;
    f32x4 v[8]; float s = 0.f;
#pragma unroll
    for (int j = 0; j < 8; ++j) { v[j] = __builtin_nontemporal_load(xr + 64 * j); s += (v[j].x * v[j].x + v[j].y * v[j].y) + (v[j].z * v[j].z + v[j].w * v[j].w); }
    const float rstd = 1.0f / sqrtf(wave_sum(s) * (1.0f / DM) + RMS_EPS);
    unsigned long long* o8 = (unsigned long long*)orow + lane;
#pragma unroll
    for (int j = 0; j < 8; ++j) { v[j] = g ? v[j] * rstd * gr[64 * j] : v[j] * rstd;
        o8[64 * j] = (unsigned long long)pk2(v[j].x, v[j].y) | ((unsigned long long)pk2(v[j].z, v[j].w) << 32); }
    if (wf != nullptr) {
        float my = 0.f;
#pragma unroll
        for (int c = 0; c < 8; ++c) { const f32x4* wr = (const f32x4*)(wf + c * DM) + lane; float a = 0.f;
#pragma unroll
            for (int j = 0; j < 8; ++j) { const f32x4 w = wr[64 * j]; a += (v[j].x * w.x + v[j].y * w.y) + (v[j].z * w.z + v[j].w * w.w); }
            a = wave_sum(a); if (lane == c) my = a; }
        if (lane < 8) { const float z = my + fbias[lane]; logf_row[lane] = fminf(z, 0.f) - log1pf(expf(-fabsf(z))); }
    }
}

__global__ void __launch_bounds__(NTHREADS, 2) hybrid_fwd(Args a) {
    extern __shared__ __attribute__((aligned(16))) unsigned char lds[];
    const int tid = threadIdx.x, lane = tid & 63, wave = __builtin_amdgcn_readfirstlane(tid >> 6);
    const int G = gridDim.x, bx = blockIdx.x;
    const int gw = bx * NWAVES + wave, NGW = G * NWAVES;
    unsigned char* ws = a.ws;
    bf16* W1I = (bf16*)(ws + WS_W1I); bf16* W1O = (bf16*)(ws + WS_W1O); bf16* WIN = (bf16*)(ws + WS_WIN); bf16* WOUT = (bf16*)(ws + WS_WOUT);
    bf16* W2I = (bf16*)(ws + WS_W2I); bf16* W2O = (bf16*)(ws + WS_W2O);
    bf16* H = (bf16*)(ws + WS_H); bf16* ACT = (bf16*)(ws + WS_ACT); bf16* OPART = (bf16*)(ws + WS_OPART);
    bf16* WFB = (bf16*)(ws + WS_WF); float* LOGF = (float*)(ws + WS_LOGF); float* PSS = (float*)(ws + WS_PSS);
    float* DEN = (float*)(ws + WS_STAT); float* MX = DEN + 3 * MROWS * 8;
    float* TBL = (float*)(ws + WS_TBL);
    bf16* X1B = (bf16*)a.out;
    bf16* X2B = (bf16*)(ws + WS_W1I);
    bf16* FPART = (bf16*)(ws + WS_W1I); float* FDEN = (float*)(ws + WS_FSTAT); float* FMX = FDEN + 640 * 256;
    unsigned* CTL = (unsigned*)(ws + WS_CTL);
    LAS unsigned char* ldsl = (LAS unsigned char*)lds;
    const int lo = a.ph_lo, hi = a.ph_hi;
#ifdef ONLY_PHASE
#define IN(k) ((k) == ONLY_PHASE)
#else
#define IN(k) (lo <= (k) && (k) < hi)
#endif
#if MK_MULTI
#define GRID_SYNC() do {} while (0)
#else
    for (int u = tid; u < 32; u += NTHREADS) ((LAS unsigned*)(ldsl + MISC_OFF))[u] = 0u;
    __syncthreads();
    XcdBarrier bar = xcd_barrier_post(CTL + CW_BAR, (volatile LAS unsigned*)(ldsl + MISC_OFF) + 8);
#define grid_sync_() xcd_barrier(bar)
#ifdef PROBE_K
    unsigned long long t_prev = __builtin_amdgcn_s_memrealtime(); int ph_ctr = 0;
#define GRID_SYNC() do { grid_sync_(); { const unsigned long long now_ = __builtin_amdgcn_s_memrealtime(); \
        if (ph_ctr == PROBE_K) { const unsigned long long tgt_ = now_ + (now_ - t_prev); while (__builtin_amdgcn_s_memrealtime() < tgt_) __builtin_amdgcn_s_sleep(8); } \
        t_prev = __builtin_amdgcn_s_memrealtime(); ++ph_ctr; } } while (0)
#else
#define GRID_SYNC() grid_sync_()
#endif
#endif

#ifdef REPEAT_P0
    for (int rep_ = 0; rep_ < 2; ++rep_)
#endif
    if (IN(0)) {
        if (bx == 1 % G) { const int k = tid >> 7, j = tid & 127; const float* gp = (k == 0) ? a.gains[0] : (k == 1) ? a.gains[1] : (k == 2) ? a.gains[2] : a.gains[3];
            ((float*)(CTL + 256))[tid] = gp[j]; }
        { LAS unsigned* Tw = (LAS unsigned*)(ldsl + wave * 8192);
          CONV_RANGE(0, CV_E0, gw, NGW, Tw, false);
          CONV_RANGE(CV_E2, CV_E4, gw, NGW, Tw, true); }
        if (bx >= 8 && bx < 32 && tid < att::TB_N) {
            const int ph = bx - 8, pat = ph >> 3, hd = ph & 7, dil = (pat == 0) ? 1 : (pat == 1) ? 4 : 16, delta = tid - att::TB_PAD; float v = 0.f;
            if (delta >= 0 && delta <= 128) {
                const int dist = delta * dil; int bucket;
                if (dist < 16) bucket = dist;
                else { const float dd = (float)dist; int lg = 16 + (int)(logf(dd / 16.0f) / 4.852030263919617f * 16.0f); bucket = lg < 31 ? lg : 31; }
                v = a.rel[bucket * 8 + hd] * att::INV_SCALE;
            }
            TBL[ph * att::TB_N + tid] = v;
        }
        for (int i = bx * NTHREADS + tid; i < 16 * DM; i += G * NTHREADS) { const int c = i / DM, k = i % DM; WFB[i] = (c < 8) ? (bf16)f2bf(a.win[(size_t)k * DPROJ + NQKV + c] * a.nmix[k]) : (bf16)0; }
        for (int m = gw; m < MROWS; m += NGW) norm_row(a.x + (size_t)m * DM, nullptr, H + (size_t)m * DM, lane, nullptr, nullptr, nullptr);
        if (hi > 1) GRID_SYNC();
    }
    if (IN(1)) {
        pg8::Gemm g{H, W1I, MROWS, 2 * DFF, DM}; pg8::StaticOrder S; S.init(MROWS, 2 * DFF, G, bx);
        pg8::EpiSwiglu E{ACT, DFF, nullptr};
        pg8::gemm_phase<pg8::EpiSwiglu, pg8::StaticOrder, true, true>(ldsl, g, S, E);
        { const int rem = ((MROWS / 256) * (2 * DFF / 256)) % G;
          if (rem > 0 && bx >= rem) { LAS unsigned* Tw = (LAS unsigned*)(ldsl + wave * 8192); CONV_RANGE(CV_E0, CV_E2, (bx - rem) * NWAVES + wave, (G - rem) * NWAVES, Tw, false); }
          else if (rem == 0) { LAS unsigned* Tw = (LAS unsigned*)(ldsl + wave * 8192); CONV_RANGE(CV_E0, CV_E2, gw, NGW, Tw, false); } }
        if (hi > 2) GRID_SYNC();
    }
    if (IN(2)) {
        pg8::Gemm g{ACT, W1O, MROWS, DM, DFF}; pg8::StaticOrder S; S.init(MROWS, DM, G, bx);
        pg8::EpiResNorm2<false> E{a.x, X1B, DM, 0.5f, PSS};
        pg8::gemm_phase<pg8::EpiResNorm2<false>, pg8::StaticOrder, false, true>(ldsl, g, S, E);
        if (hi > 4) GRID_SYNC();
    }
    if (IN(4)) {
        {
            typedef short bf16x8v __attribute__((ext_vector_type(8)));
            LAS float* red = (LAS float*)ldsl;
            for (int blk = bx; blk < MROWS / 32; blk += G) {
                const int rowbase = blk * 32;
                const bf16* ap = X1B + (size_t)(rowbase + (lane & 15)) * DM + wave * 256 + 8 * (lane >> 4);
                const bf16* bp = WFB + (size_t)(lane & 15) * DM + wave * 256 + 8 * (lane >> 4);
                bf16x8v av0[8], av1[8], bv[8];
#pragma unroll
                for (int ks = 0; ks < 8; ++ks) { av0[ks] = *(const bf16x8v*)(ap + 32 * ks); av1[ks] = *(const bf16x8v*)(ap + (size_t)16 * DM + 32 * ks); bv[ks] = *(const bf16x8v*)(bp + 32 * ks); }
                f32x4 acc0 = {0.f, 0.f, 0.f, 0.f}, acc1 = {0.f, 0.f, 0.f, 0.f};
#pragma unroll
                for (int ks = 0; ks < 8; ++ks) { acc0 = __builtin_amdgcn_mfma_f32_16x16x32_bf16(av0[ks], bv[ks], acc0, 0, 0, 0); acc1 = __builtin_amdgcn_mfma_f32_16x16x32_bf16(av1[ks], bv[ks], acc1, 0, 0, 0); }
                *(LAS f32x4*)(red + ((wave * 2 + 0) * 64 + lane) * 4) = acc0; *(LAS f32x4*)(red + ((wave * 2 + 1) * 64 + lane) * 4) = acc1;
                __syncthreads();
                if (wave < 2) {
                    f32x4 accf = {0.f, 0.f, 0.f, 0.f};
#pragma unroll
                    for (int w = 0; w < 8; ++w) accf += *(const LAS f32x4*)(red + ((w * 2 + wave) * 64 + lane) * 4);
                    const int c = lane & 15, r4 = rowbase + wave * 16 + 4 * (lane >> 4);
                    if (c < 8) {
                        const float fb = a.fbias[c]; f32x4 o;
#pragma unroll
                        for (int j = 0; j < 4; ++j) {
                            const f32x4 p0 = *(const f32x4*)(PSS + (size_t)(r4 + j) * 8), p1 = *(const f32x4*)(PSS + (size_t)(r4 + j) * 8 + 4);
                            const float rstd = 1.0f / sqrtf((((p0[0] + p0[1]) + (p0[2] + p0[3])) + ((p1[0] + p1[1]) + (p1[2] + p1[3]))) * (1.0f / DM) + RMS_EPS);
                            const float z = accf[j] * rstd + fb;
                            o[j] = fminf(z, 0.f) - log1pf(expf(-fabsf(z)));
                        }
                        const int b = r4 / SEQ, t = r4 % SEQ;
                        *(f32x4*)(LOGF + ((size_t)(b * 8 + c)) * SEQ + t) = o;
                    }
                }
                __syncthreads();
            }
        }
        pg8::Gemm g{X1B, WIN, MROWS, NQKV, DM}; pg8::StaticOrder S; S.init(MROWS, NQKV, G, bx);
        FILL_RS(S);
        { LAS float* gl = (LAS float*)(ldsl + GN_OFF); gl[tid] = ((const float*)(CTL + 256))[tid]; __syncthreads(); }
        pg8::EpiQKV E{ACT, NQKV, (const LAS float*)(ldsl + GN_OFF), (const LAS float*)(ldsl + RS_OFF), (LAS float*)(ldsl + XCH_OFF)};
#ifdef PROBE_EPI
        if (tid == 0) *(volatile LAS unsigned*)(ldsl + MISC_OFF + 64) = 0u;
        __syncthreads();
#endif
        pg8::gemm_phase<pg8::EpiQKV, pg8::StaticOrder, true, true>(ldsl, g, S, E);
#ifdef PROBE_EPI
        __syncthreads();
        { const unsigned tot_ = *(volatile LAS unsigned*)(ldsl + MISC_OFF + 64) / 512u;
          const unsigned long long t0_ = __builtin_amdgcn_s_memrealtime(); while (__builtin_amdgcn_s_memrealtime() - t0_ < tot_) __builtin_amdgcn_s_sleep(8); }
#endif
        if (hi > 5) GRID_SYNC();
    }
#ifdef REPEAT_P5
    for (int rep5_ = 0; rep5_ < 2; ++rep5_)
#else
    constexpr int rep5_ = 0;
#endif
    if (IN(5)) {
        LAS unsigned* misc = (LAS unsigned*)(ldsl + MISC_OFF);
        const bf16* QKV = ACT; constexpr int NFOX = 384;
        float skip_thr;
        { const float* gt = (const float*)(CTL + 256);
          float gq = fmaxf(fabsf(gt[256 + lane]), fabsf(gt[256 + 64 + lane])), gk = fmaxf(fabsf(gt[384 + lane]), fabsf(gt[384 + 64 + lane]));
#pragma unroll
          for (int o = 1; o < 64; o <<= 1) { gq = fmaxf(gq, __shfl_xor(gq, o)); gk = fmaxf(gk, __shfl_xor(gk, o)); }
          const float smax = 128.0f * att::SCALE * gq * gk * 1.0001f;
          skip_thr = __uint_as_float(__builtin_amdgcn_readfirstlane(__float_as_uint(-(110.0f + 2.0f * smax) * att::INV_SCALE))); }
#ifdef PROBE_ATT
        if (tid == 0) *(volatile LAS unsigned*)(ldsl + MISC_OFF + 68) = 0u;
        const unsigned long long tp0_ = __builtin_amdgcn_s_memrealtime();
#endif
#ifdef PROBE_CAT
        unsigned long long cat_acc_ = 0;
#endif
#ifdef PROBE_DIL
        if (tid == 0) *(volatile LAS unsigned*)(ldsl + MISC_OFF + 72) = 0u;
#endif
        if (tid == 0) misc[0] = atomicAdd(CTL + rep5_, 1u);
        __syncthreads();
        unsigned nxt_id = 0u;
        for (int kq = 0;; ++kq) {
            const int ui = __builtin_amdgcn_readfirstlane((int)misc[kq & 1]);
            if (ui >= NFOX + 768) break;
            att::UnitD U;
            if (ui < NFOX) {
                const int bh = ui & 15, v = ui >> 4, b = bh >> 3, h = bh & 7; int qb, part;
                if (v < 16) { qb = 15 - (v >> 1); part = v & 1; } else { qb = 23 - v; part = -1; }
                const bf16* base = QKV + (size_t)b * SEQ * NQKV;
                U.Q = base + 3072 + h * HD; U.K = base + 4096 + h * HD; U.V = base + 5120 + h * HD; U.pitch = NQKV;
                U.lf = LOGF + (size_t)bh * SEQ; U.rel = nullptr; U.head = h; U.dil = 1;
                U.q0 = qb * 256; U.W = 0x7fffffff; U.skip_thr = skip_thr;
                if (part < 0) { U.O = H + (size_t)b * SEQ * DM + 1024 + h * HD; U.opitch = DM; U.den = nullptr; U.mx = nullptr; U.spitch = 0; U.jlo = 0; U.jhi = qb * 4 + 4; }
                else { const int slot = bh * 16 + (qb - 8) * 2 + part;
                    U.O = FPART + (size_t)slot * 256 * HD - (size_t)qb * 256 * HD; U.opitch = HD;
                    U.den = FDEN + slot * 256 - qb * 256; U.mx = FMX + slot * 256 - qb * 256; U.spitch = 1;
                    U.jlo = part * 32; U.jhi = part ? qb * 4 + 4 : 32; }
            } else {
                const int r = ui - NFOX, u16 = r & 15, pbh = r >> 4, bh = pbh & 15, p = pbh >> 4, b = bh >> 3, h = bh & 7;
                const int dil = (p == 0) ? 1 : (p == 1) ? 4 : 16;
                int z, n;
                if (p == 0) { z = 0; n = u16; } else if (p == 1) { z = u16 >> 2; n = u16 & 3; } else { z = u16; n = 0; }
                const bf16* base = QKV + ((size_t)b * SEQ + z) * NQKV;
                U.Q = base + h * HD; U.K = base + 1024 + h * HD; U.V = base + 2048 + h * HD; U.pitch = dil * NQKV;
                U.O = OPART + (size_t)p * MROWS * 1024 + ((size_t)b * SEQ + z) * 1024 + h * HD; U.opitch = dil * 1024;
                U.den = DEN + (size_t)p * MROWS * 8 + ((size_t)b * SEQ + z) * 8 + h; U.mx = MX + (size_t)p * MROWS * 8 + ((size_t)b * SEQ + z) * 8 + h; U.spitch = dil * 8;
                U.lf = nullptr; U.rel = TBL + (p * 8 + h) * att::TB_N; U.head = h; U.dil = dil;
                U.q0 = n * 256; U.jlo = (n == 0) ? 0 : n * 4 - 2; U.jhi = n * 4 + 4; U.W = 129; U.skip_thr = 0.f;
            }
#ifdef PROBE_CAT
            const unsigned long long tu0_ = __builtin_amdgcn_s_memrealtime();
#endif
            if (ui < NFOX) att::attn_unit<true>(U, (ALAS char*)ldsl, CTL + rep5_, nxt_id); else att::attn_unit_dil(U, (ALAS char*)ldsl, CTL + rep5_, nxt_id);
#ifdef PROBE_CAT
            if ((ui < NFOX) == (PROBE_CAT == 0)) cat_acc_ += __builtin_amdgcn_s_memrealtime() - tu0_;
#endif
            if (tid == 0) misc[(kq + 1) & 1] = nxt_id;
            __syncthreads();
        }
#ifdef PROBE_CAT
        { const unsigned long long t0_ = __builtin_amdgcn_s_memrealtime(); while (__builtin_amdgcn_s_memrealtime() - t0_ < cat_acc_) __builtin_amdgcn_s_sleep(8); }
#endif
#ifdef PROBE_DIL
        { __syncthreads(); const unsigned acc_ = *(volatile LAS unsigned*)(ldsl + MISC_OFF + 72); const unsigned long long t0_ = __builtin_amdgcn_s_memrealtime(); while (__builtin_amdgcn_s_memrealtime() - t0_ < acc_) __builtin_amdgcn_s_sleep(8); }
#endif
#ifdef PROBE_ATT
        {
            __syncthreads();
            const unsigned long long tot_ = __builtin_amdgcn_s_memrealtime() - tp0_; const unsigned loop_ = *(volatile LAS unsigned*)(ldsl + MISC_OFF + 68);
            const unsigned long long ovh_ = tot_ > loop_ ? tot_ - loop_ : 0ull, t0_ = __builtin_amdgcn_s_memrealtime();
            while (__builtin_amdgcn_s_memrealtime() - t0_ < ovh_) __builtin_amdgcn_s_sleep(8); }
#endif
        if (hi > 6) GRID_SYNC();
    }
    if (IN(6)) {
#define P6_LOAD(X, gi_) const size_t pair##X = (gi_) >> 4; const int part##X = (int)((gi_) & 15); const size_t token##X = pair##X >> 4; const int hh##X = (int)(pair##X & 15);   \
            const bool fox##X = hh##X >= 8; const int b##X = (int)(token##X / SEQ), t##X = (int)(token##X % SEQ), qb##X = t##X >> 8, r##X = t##X & 255;                          \
            const bool live##X = !fox##X || qb##X >= 8; const int slot##X = (b##X * 8 + (hh##X & 7)) * 16 + ((qb##X - 8) & 7) * 2;                                            \
            const size_t sd##X = token##X * 8 + (hh##X & 7);                                                                                                                \
            const float* mp0##X = fox##X ? FMX + (size_t)slot##X * 256 + r##X : MX + sd##X; const float* mp1##X = fox##X ? mp0##X + 256 : mp0##X + (size_t)MROWS * 8;           \
            const float* lp0##X = fox##X ? FDEN + (size_t)slot##X * 256 + r##X : DEN + sd##X; const float* lp1##X = fox##X ? lp0##X + 256 : lp0##X + (size_t)MROWS * 8;         \
            const bf16* op0##X = fox##X ? FPART + ((size_t)slot##X * 256 + r##X) * HD + part##X * 8 : OPART + token##X * 1024 + (hh##X & 7) * HD + part##X * 8;                  \
            const bf16* op1##X = fox##X ? op0##X + (size_t)256 * HD : op0##X + (size_t)MROWS * 1024; const bf16* op2##X = fox##X ? op0##X : op0##X + (size_t)2 * MROWS * 1024;    \
            const float m0##X = *mp0##X, m1##X = *mp1##X, m2##X = fox##X ? -1e30f : mp0##X[(size_t)2 * MROWS * 8];                                                             \
            const float l0##X = *lp0##X, l1##X = *lp1##X, l2##X = fox##X ? 0.f : lp0##X[(size_t)2 * MROWS * 8];                                                                \
            const u32x4v q0##X = __builtin_nontemporal_load((const u32x4v*)op0##X), q1##X = __builtin_nontemporal_load((const u32x4v*)op1##X), q2##X = __builtin_nontemporal_load((const u32x4v*)op2##X);
#define P6_ACC(acc_, w_, q_) do { const unsigned qq_[4] = {q_.x, q_.y, q_.z, q_.w};                                                                                          \
            _Pragma("unroll") for (int j = 0; j < 4; ++j) { acc_[2 * j] += (w_) * __uint_as_float(qq_[j] << 16); acc_[2 * j + 1] += (w_) * __uint_as_float(qq_[j] & 0xffff0000u); } } while (0)
#define P6_FIN(X) do { const float mm_ = fmaxf(m0##X, fmaxf(m1##X, m2##X));                                                                                                   \
            const float w0_ = l0##X * __builtin_amdgcn_exp2f((m0##X - mm_) * att::C2), w1_ = l1##X * __builtin_amdgcn_exp2f((m1##X - mm_) * att::C2), w2_ = l2##X * __builtin_amdgcn_exp2f((m2##X - mm_) * att::C2); \
            float acc_[8] = {0.f, 0.f, 0.f, 0.f, 0.f, 0.f, 0.f, 0.f}; P6_ACC(acc_, w0_, q0##X); P6_ACC(acc_, w1_, q1##X); P6_ACC(acc_, w2_, q2##X);                              \
            const float inv_ = 1.0f / (w0_ + w1_ + w2_);                                                                                                                     \
            u32x4v o_; o_.x = pk2(acc_[0] * inv_, acc_[1] * inv_); o_.y = pk2(acc_[2] * inv_, acc_[3] * inv_); o_.z = pk2(acc_[4] * inv_, acc_[5] * inv_); o_.w = pk2(acc_[6] * inv_, acc_[7] * inv_); \
            if (live##X) *(u32x4v*)(H + token##X * DM + hh##X * HD + part##X * 8) = o_; } while (0)
        const size_t NIT = (size_t)MROWS * 16 * 16, stride = (size_t)G * NTHREADS;
        for (size_t gidx = (size_t)bx * NTHREADS + tid; gidx < NIT; gidx += 2 * stride) {
            const size_t g2 = gidx + stride < NIT ? gidx + stride : gidx;
            P6_LOAD(A, gidx) P6_LOAD(B, g2)
            P6_FIN(A); P6_FIN(B);
        }
#undef P6_LOAD
#undef P6_ACC
#undef P6_FIN
        if (hi > 7) GRID_SYNC();
#ifdef PROBE_BAR
        for (int i_ = 0; i_ < 8; ++i_) GRID_SYNC();
#endif
    }
    if (IN(7)) {
        pg8::Gemm g{H, WOUT, MROWS, DM, DM}; pg8::StaticOrder S; S.init(MROWS, DM, G, bx);
        pg8::EpiResNorm2<true> E{X1B, X2B, DM, 1.0f, PSS};
        pg8::gemm_phase<pg8::EpiResNorm2<true>, pg8::StaticOrder, false, true>(ldsl, g, S, E);
        if (hi > 9) GRID_SYNC();
    }
    if (IN(9)) {
        pg8::Gemm g{X2B, W2I, MROWS, 2 * DFF, DM}; pg8::StaticOrder S; S.init(MROWS, 2 * DFF, G, bx);
        FILL_RS(S);
        pg8::EpiSwiglu E{ACT, DFF, (const LAS float*)(ldsl + RS_OFF)};
        pg8::gemm_phase<pg8::EpiSwiglu, pg8::StaticOrder, true, true>(ldsl, g, S, E);
        { const int rem = ((MROWS / 256) * (2 * DFF / 256)) % G;
          if (rem > 0 && bx >= rem) { LAS unsigned* Tw = (LAS unsigned*)(ldsl + wave * 8192); CONV_RANGE(CV_E4, CV_E5, (bx - rem) * NWAVES + wave, (G - rem) * NWAVES, Tw, false); }
          else if (rem == 0) { LAS unsigned* Tw = (LAS unsigned*)(ldsl + wave * 8192); CONV_RANGE(CV_E4, CV_E5, gw, NGW, Tw, false); } }
        if (hi > 10) GRID_SYNC();
    }
    if (IN(10)) {
        pg8::Gemm g{ACT, W2O, MROWS, DM, DFF}; pg8::StaticOrder S; S.init(MROWS, DM, G, bx);
        pg8::EpiRes2 E{X2B, a.out, DM, 0.5f};
        pg8::gemm_phase<pg8::EpiRes2, pg8::StaticOrder, false, true>(ldsl, g, S, E);
    }
#ifdef PROBE_K
    GRID_SYNC();
#endif
#undef IN
}

extern "C" void kernel_launch(void* const* d_in, const int* in_sizes, int n_in, void* d_out, int out_size, void* d_ws, size_t ws_size, hipStream_t stream) {
    static int grid = 0;
    if (grid == 0) {
        int dev = 0, cus = 0, per_cu = 0;
        if (hipGetDevice(&dev) != hipSuccess || hipDeviceGetAttribute(&cus, hipDeviceAttributeMultiprocessorCount, dev) != hipSuccess) { fprintf(stderr, "kernel_launch: device query failed\n"); grid = -1; return; }
        if (hipFuncSetAttribute((const void*)hybrid_fwd, hipFuncAttributeMaxDynamicSharedMemorySize, LDS_BYTES) != hipSuccess) { fprintf(stderr, "kernel_launch: hipFuncSetAttribute failed\n"); grid = -1; return; }
        if (hipOccupancyMaxActiveBlocksPerMultiprocessor(&per_cu, (const void*)hybrid_fwd, NTHREADS, LDS_BYTES) != hipSuccess || per_cu < 1) fprintf(stderr, "kernel_launch: occupancy query says %d\n", per_cu);
        (void)hipGetLastError();
        if (ws_size < WS_END) { fprintf(stderr, "kernel_launch: workspace too small (%zu < %zu)\n", ws_size, (size_t)WS_END); grid = -1; return; }
        grid = cus;
    }
    if (grid < 0) return;
    Args a{};
    a.x = (const float*)d_in[0]; a.n1 = (const float*)d_in[1]; a.w1i = (const float*)d_in[2]; a.w1o = (const float*)d_in[3]; a.nmix = (const float*)d_in[4];
    a.win = (const float*)d_in[5]; a.gains[0] = (const float*)d_in[6]; a.gains[1] = (const float*)d_in[7]; a.gains[2] = (const float*)d_in[8]; a.gains[3] = (const float*)d_in[9];
    a.fbias = (const float*)d_in[10]; a.rel = (const float*)d_in[11]; a.wout = (const float*)d_in[12]; a.n2 = (const float*)d_in[13]; a.w2i = (const float*)d_in[14]; a.w2o = (const float*)d_in[15];
    a.out = (float*)d_out; a.ws = (unsigned char*)d_ws;
    if (hipMemsetAsync((char*)d_ws + WS_CTL, 0, CTL_ZERO_BYTES, stream) != hipSuccess) { fprintf(stderr, "kernel_launch: memset failed\n"); return; }
#if MK_MULTI
    for (int p = 0; p <= 10; ++p) { a.ph_lo = p; a.ph_hi = p + 1; hipLaunchKernelGGL(hybrid_fwd, dim3(grid), dim3(NTHREADS), LDS_BYTES, stream, a); }
#else
    a.ph_lo = 0; a.ph_hi = 11;
    hipLaunchKernelGGL(hybrid_fwd, dim3(grid), dim3(NTHREADS), LDS_BYTES, stream, a);
    const hipError_t e = hipPeekAtLastError();
    if (e != hipSuccess) fprintf(stderr, "kernel_launch: launch failed: %s (grid %d)\n", hipGetErrorString(e), grid);
#endif
}
```

```cpp
#include <hip/hip_runtime.h>
#include <cstdio>
#include <cstdint>

#ifndef MK_MULTI
#define MK_MULTI 0
#endif

namespace pg8 {
#define PG8_LAS __attribute__((address_space(3)))
typedef unsigned short bf16_t;
typedef short bf16x8 __attribute__((ext_vector_type(8)));
typedef float f32x4 __attribute__((ext_vector_type(4)));
typedef unsigned u32x4 __attribute__((ext_vector_type(4)));
constexpr int BM = 256, BK = 64, HALF = 128, HTB = HALF * BK * 2  , STAGE_BYTES = 8 * HTB, NXCD = 8, WGM = 8;

__host__ __device__ __forceinline__ int lds_byte(int r, int c) { const int st = (r >> 4) * 2 + (c >> 5), rr = r & 15, cc = c & 31, ob = rr * 64 + cc * 2; return st * 1024 + (ob ^ (((ob >> 9) & 1) << 5)); }
__host__ __device__ __forceinline__ void stage_rc(int b, int& R, int& C) { const int st = b / 1024, sb = b % 1024, swz = sb ^ (((sb >> 9) & 1) << 5); R = (st >> 1) * 16 + swz / 64; C = (st & 1) * 32 + (swz % 64) / 2; }
__host__ __device__ __forceinline__ int perm32(int rho) { const int n = rho >> 4, i = rho & 15; return 8 * (i >> 2) + 4 * n + (i & 3); }

struct Unit { int pm, pn, ord; };
struct Gemm { const bf16_t* A; const bf16_t* Bt; int M, N, K; };

struct StaticOrder {
    int nM, nN, nwg, G, c;
    __host__ __device__ void init(int M, int N, int G_, int c_) { nM = M / BM; nN = N / BM; nwg = nM * nN; G = G_; c = c_; }
    __host__ __device__ __forceinline__ bool next(int i, Unit& u) const {
        const long L = (long)i * G + c; if (L >= nwg) return false;
        int wgid = (int)L; { const int q = nwg / NXCD, r = nwg % NXCD, xcd = wgid % NXCD, off = wgid / NXCD; wgid = (xcd < r ? xcd * (q + 1) : r * (q + 1) + (xcd - r) * q) + off; }
        const int nig = WGM * nN, gid = wgid / nig, fm = gid * WGM, gsz = (nM - fm) < WGM ? (nM - fm) : WGM;
        u.pm = fm + ((wgid % nig) % gsz); u.pn = (wgid % nig) / gsz; u.ord = i; return true;
    }
    __device__ __forceinline__ void a_ready(const Unit&) const {}
    __device__ __forceinline__ void done(const Unit&) const {}
};

__device__ __forceinline__ unsigned cvt_pk_bf16(float lo, float hi) { unsigned r; asm volatile("v_cvt_pk_bf16_f32 %0, %1, %2" : "=v"(r) : "v"(lo), "v"(hi)); return r; }


typedef float f32x2 __attribute__((ext_vector_type(2)));

__device__ __forceinline__ float row_rstd8(const float* PSS, int row, int fq) {
    const f32x2 p = *(const f32x2*)(PSS + (size_t)row * 8 + 2 * fq); float s = p.x + p.y;
    s += __shfl_xor(s, 16); s += __shfl_xor(s, 32);
    return __builtin_amdgcn_rsqf(s * (1.0f / 2048.0f) + 1e-6f);
}
struct EpiSwiglu {
    static constexpr bool PERM = true, AFTER_DRAIN = false;
    bf16_t* O; int ldc; const PG8_LAS float* RS;
    __device__ __forceinline__ void operator()(const f32x4 (&acc)[2][2][4][2], const Unit& u, int wr, int wc, int fr, int fq) const {
        const int row0 = u.pm * BM + wr * 64 + fr, col0 = u.pn * HALF + wc * 32 + 8 * fq;
        float rsd[2][4];
#pragma unroll
        for (int ai = 0; ai < 2; ++ai)
#pragma unroll
            for (int m = 0; m < 4; ++m) rsd[ai][m] = RS ? RS[u.ord * 256 + ai * HALF + wr * 64 + m * 16 + fr] : 1.0f;
#pragma unroll
        for (int ai = 0; ai < 2; ++ai)
#pragma unroll
            for (int m = 0; m < 4; ++m) {
                bf16_t* rowp = O + (size_t)(row0 + ai * HALF + m * 16) * ldc + col0;
                float r[8];
#pragma unroll
                for (int n = 0; n < 2; ++n)
#pragma unroll
                    for (int j = 0; j < 4; ++j) {
                        const float g = acc[ai][0][m][n][j] * rsd[ai][m], up = acc[ai][1][m][n][j] * rsd[ai][m];
                        const float e = __builtin_amdgcn_exp2f(-1.4426950408889634f * g);
                        r[n * 4 + j] = g * __builtin_amdgcn_rcpf(1.0f + e) * up;
                    }
                u32x4 w; w.x = cvt_pk_bf16(r[0], r[1]); w.y = cvt_pk_bf16(r[2], r[3]); w.z = cvt_pk_bf16(r[4], r[5]); w.w = cvt_pk_bf16(r[6], r[7]);
                *(u32x4*)rowp = w;
            }
    }
};
struct EpiRes {
    static constexpr bool PERM = false, AFTER_DRAIN = false;
    const float* base; float* out; int ldc; float scale;
    __device__ __forceinline__ void operator()(const f32x4 (&acc)[2][2][4][2], const Unit& u, int wr, int wc, int fr, int fq) const {
        const int row0 = u.pm * BM + wr * 64 + fr, col0 = u.pn * BM + wc * 32 + 4 * fq;
        f32x4 bq[2][2][2];
#pragma unroll
        for (int bj = 0; bj < 2; ++bj)
#pragma unroll
            for (int n = 0; n < 2; ++n) bq[0][bj][n] = __builtin_nontemporal_load((const f32x4*)(base + (size_t)row0 * ldc + col0 + bj * HALF + n * 16));
#pragma unroll
        for (int it = 0; it < 8; ++it) {
            const int ai = it >> 2, m = it & 3;
            const size_t off = (size_t)(row0 + ai * HALF + m * 16) * ldc + col0;
            if (it + 1 < 8) { const size_t offn = (size_t)(row0 + ((it + 1) >> 2) * HALF + ((it + 1) & 3) * 16) * ldc + col0;
#pragma unroll
                for (int bj = 0; bj < 2; ++bj)
#pragma unroll
                    for (int n = 0; n < 2; ++n) bq[(it + 1) & 1][bj][n] = __builtin_nontemporal_load((const f32x4*)(base + offn + bj * HALF + n * 16)); }
#pragma unroll
            for (int bj = 0; bj < 2; ++bj)
#pragma unroll
                for (int n = 0; n < 2; ++n) __builtin_nontemporal_store(bq[it & 1][bj][n] + acc[ai][bj][m][n] * scale, (f32x4*)(out + off + bj * HALF + n * 16));
        }
    }
};
struct EpiResNorm {
    static constexpr bool PERM = false, AFTER_DRAIN = true;
    const float* base; float* out; int ldc; float scale; const float* gain; bf16_t* XG; float* PSS;
    __device__ __forceinline__ void fused(const f32x4 (&acc)[2][2][4][2], const Unit& u, int wr, int wc, int fr, int fq, PG8_LAS unsigned char* lds, int wid, int lane) const {
        typedef unsigned u32x2 __attribute__((ext_vector_type(2)));
        const int row0 = u.pm * BM + wr * 64 + fr, col0 = u.pn * BM + wc * 32 + 4 * fq;
        PG8_LAS float* P = (PG8_LAS float*)lds;
        f32x4 gv[2][2];
#pragma unroll
        for (int bj = 0; bj < 2; ++bj)
#pragma unroll
            for (int n = 0; n < 2; ++n) gv[bj][n] = *(const f32x4*)(gain + col0 + bj * HALF + n * 16);
        f32x4 bq[2][2][2];
#pragma unroll
        for (int bj = 0; bj < 2; ++bj)
#pragma unroll
            for (int n = 0; n < 2; ++n) bq[0][bj][n] = __builtin_nontemporal_load((const f32x4*)(base + (size_t)row0 * ldc + col0 + bj * HALF + n * 16));
#pragma unroll
        for (int it = 0; it < 8; ++it) {
            const int ai = it >> 2, m = it & 3;
            const size_t off = (size_t)(row0 + ai * HALF + m * 16) * ldc + col0;
            if (it + 1 < 8) { const size_t offn = (size_t)(row0 + ((it + 1) >> 2) * HALF + ((it + 1) & 3) * 16) * ldc + col0;
#pragma unroll
                for (int bj = 0; bj < 2; ++bj)
#pragma unroll
                    for (int n = 0; n < 2; ++n) bq[(it + 1) & 1][bj][n] = __builtin_nontemporal_load((const f32x4*)(base + offn + bj * HALF + n * 16)); }
            float ss = 0.f;
#pragma unroll
            for (int bj = 0; bj < 2; ++bj)
#pragma unroll
                for (int n = 0; n < 2; ++n) {
                    const f32x4 x1 = bq[it & 1][bj][n] + acc[ai][bj][m][n] * scale;
                    *(f32x4*)(out + off + bj * HALF + n * 16) = x1;
                    ss += (x1[0] * x1[0] + x1[1] * x1[1]) + (x1[2] * x1[2] + x1[3] * x1[3]);
                    const f32x4 xg = x1 * gv[bj][n];
                    u32x2 w; w.x = cvt_pk_bf16(xg[0], xg[1]); w.y = cvt_pk_bf16(xg[2], xg[3]);
                    *(u32x2*)(XG + off + bj * HALF + n * 16) = w;
                }
            ss += __shfl_xor(ss, 16); ss += __shfl_xor(ss, 32);
            if (fq == 0) P[(ai * HALF + wr * 64 + m * 16 + fr) * 4 + wc] = ss;
        }
        asm volatile("s_waitcnt lgkmcnt(0)" ::: "memory"); __builtin_amdgcn_s_barrier(); asm volatile("" ::: "memory");
        const int t = wid * 64 + lane;
        if (t < 256) { const f32x4 p = *(const PG8_LAS f32x4*)(P + t * 4); PSS[(size_t)(u.pm * BM + t) * 8 + u.pn] = (p[0] + p[1]) + (p[2] + p[3]); }
    }
};
__device__ __forceinline__ void bf8_to_f32(const u32x4 q, float (&f)[8]) {
    f[0] = __uint_as_float(q.x << 16); f[1] = __uint_as_float(q.x & 0xffff0000u); f[2] = __uint_as_float(q.y << 16); f[3] = __uint_as_float(q.y & 0xffff0000u);
    f[4] = __uint_as_float(q.z << 16); f[5] = __uint_as_float(q.z & 0xffff0000u); f[6] = __uint_as_float(q.w << 16); f[7] = __uint_as_float(q.w & 0xffff0000u);
}
template <bool BASE16> struct EpiResNorm2 {
    static constexpr bool PERM = true, AFTER_DRAIN = true;
    const void* base; bf16_t* XB; int ldc; float scale; float* PSS;
    __device__ __forceinline__ void fused(const f32x4 (&acc)[2][2][4][2], const Unit& u, int wr, int wc, int fr, int fq, PG8_LAS unsigned char* lds, int wid, int lane) const {
        const int row0 = u.pm * BM + wr * 64 + fr, col0 = u.pn * BM + wc * 32 + 8 * fq;
        PG8_LAS float* P = (PG8_LAS float*)lds;
        u32x4 b16[2][2]; f32x4 b32[2][2][2];
#define ERN_LOAD(slot_, off_) do { _Pragma("unroll") for (int bj = 0; bj < 2; ++bj) {                                                                \
            if constexpr (BASE16) b16[slot_][bj] = __builtin_nontemporal_load((const u32x4*)((const bf16_t*)base + (off_) + bj * HALF));            \
            else { b32[slot_][bj][0] = __builtin_nontemporal_load((const f32x4*)((const float*)base + (off_) + bj * HALF));                         \
                   b32[slot_][bj][1] = __builtin_nontemporal_load((const f32x4*)((const float*)base + (off_) + bj * HALF + 4)); } } } while (0)
        ERN_LOAD(0, (size_t)row0 * ldc + col0);
#pragma unroll
        for (int it = 0; it < 8; ++it) {
            const int ai = it >> 2, m = it & 3;
            const size_t off = (size_t)(row0 + ai * HALF + m * 16) * ldc + col0;
            if (it + 1 < 8) { const size_t offn = (size_t)(row0 + ((it + 1) >> 2) * HALF + ((it + 1) & 3) * 16) * ldc + col0; ERN_LOAD((it + 1) & 1, offn); }
            float ss = 0.f;
#pragma unroll
            for (int bj = 0; bj < 2; ++bj) {
                float bv[8];
                if constexpr (BASE16) bf8_to_f32(b16[it & 1][bj], bv);
                else { const f32x4 t0 = b32[it & 1][bj][0], t1 = b32[it & 1][bj][1]; bv[0] = t0[0]; bv[1] = t0[1]; bv[2] = t0[2]; bv[3] = t0[3]; bv[4] = t1[0]; bv[5] = t1[1]; bv[6] = t1[2]; bv[7] = t1[3]; }
                float x1[8];
#pragma unroll
                for (int j = 0; j < 4; ++j) { x1[j] = bv[j] + acc[ai][bj][m][0][j] * scale; x1[4 + j] = bv[4 + j] + acc[ai][bj][m][1][j] * scale; }
#pragma unroll
                for (int j = 0; j < 8; ++j) ss += x1[j] * x1[j];
                u32x4 wb; wb.x = cvt_pk_bf16(x1[0], x1[1]); wb.y = cvt_pk_bf16(x1[2], x1[3]); wb.z = cvt_pk_bf16(x1[4], x1[5]); wb.w = cvt_pk_bf16(x1[6], x1[7]);
                *(u32x4*)(XB + off + bj * HALF) = wb;
            }
            ss += __shfl_xor(ss, 16); ss += __shfl_xor(ss, 32);
            if (fq == 0) P[(ai * HALF + wr * 64 + m * 16 + fr) * 4 + wc] = ss;
        }
#undef ERN_LOAD
        asm volatile("s_waitcnt lgkmcnt(0)" ::: "memory"); __builtin_amdgcn_s_barrier(); asm volatile("" ::: "memory");
        const int t = wid * 64 + lane;
        if (t < 256) { const f32x4 p = *(const PG8_LAS f32x4*)(P + t * 4); PSS[(size_t)(u.pm * BM + t) * 8 + u.pn] = (p[0] + p[1]) + (p[2] + p[3]); }
    }
};
struct EpiRes2 {
    static constexpr bool PERM = true, AFTER_DRAIN = false;
    const bf16_t* base; float* out; int ldc; float scale;
    __device__ __forceinline__ void operator()(const f32x4 (&acc)[2][2][4][2], const Unit& u, int wr, int wc, int fr, int fq) const {
        const int row0 = u.pm * BM + wr * 64 + fr, col0 = u.pn * BM + wc * 32 + 8 * fq;
        u32x4 bq[2][2];
#pragma unroll
        for (int bj = 0; bj < 2; ++bj) bq[0][bj] = __builtin_nontemporal_load((const u32x4*)(base + (size_t)row0 * ldc + col0 + bj * HALF));
#pragma unroll
        for (int it = 0; it < 8; ++it) {
            const int ai = it >> 2, m = it & 3;
            const size_t off = (size_t)(row0 + ai * HALF + m * 16) * ldc + col0;
            if (it + 1 < 8) { const size_t offn = (size_t)(row0 + ((it + 1) >> 2) * HALF + ((it + 1) & 3) * 16) * ldc + col0;
#pragma unroll
                for (int bj = 0; bj < 2; ++bj) bq[(it + 1) & 1][bj] = __builtin_nontemporal_load((const u32x4*)(base + offn + bj * HALF)); }
#pragma unroll
            for (int bj = 0; bj < 2; ++bj) { float bv[8]; bf8_to_f32(bq[it & 1][bj], bv);
                const f32x4 o0 = {bv[0] + acc[ai][bj][m][0][0] * scale, bv[1] + acc[ai][bj][m][0][1] * scale, bv[2] + acc[ai][bj][m][0][2] * scale, bv[3] + acc[ai][bj][m][0][3] * scale};
                const f32x4 o1 = {bv[4] + acc[ai][bj][m][1][0] * scale, bv[5] + acc[ai][bj][m][1][1] * scale, bv[6] + acc[ai][bj][m][1][2] * scale, bv[7] + acc[ai][bj][m][1][3] * scale};
                __builtin_nontemporal_store(o0, (f32x4*)(out + off + bj * HALF)); __builtin_nontemporal_store(o1, (f32x4*)(out + off + bj * HALF + 4)); }
        }
    }
};
struct EpiQKV {
    static constexpr bool PERM = true, AFTER_DRAIN = false;
    bf16_t* O; int ldc; const PG8_LAS float* gains; const PG8_LAS float* RS;
    PG8_LAS float* xch;
    __device__ __forceinline__ void operator()(const f32x4 (&acc)[2][2][4][2], const Unit& u, int wr, int wc, int fr, int fq) const {
        const int seg = u.pn >> 2;
        const bool norm = (seg != 2) && (seg != 5);
        const int row0 = u.pm * BM + wr * 64 + fr, col0 = u.pn * BM + wc * 32 + 8 * fq;
        float rsd[2][4];
#pragma unroll
        for (int ai = 0; ai < 2; ++ai)
#pragma unroll
            for (int m = 0; m < 4; ++m) rsd[ai][m] = RS[u.ord * 256 + ai * HALF + wr * 64 + m * 16 + fr];
        if (norm) {
#pragma unroll
            for (int ai = 0; ai < 2; ++ai)
#pragma unroll
                for (int m = 0; m < 4; ++m)
#pragma unroll
                    for (int bj = 0; bj < 2; ++bj) {
                        const f32x4 a = acc[ai][bj][m][0], b = acc[ai][bj][m][1];
                        float s = (a[0] * a[0] + a[1] * a[1]) + (a[2] * a[2] + a[3] * a[3]) + (b[0] * b[0] + b[1] * b[1]) + (b[2] * b[2] + b[3] * b[3]);
                        s += __shfl_xor(s, 16); s += __shfl_xor(s, 32);
                        if (fq == 0) xch[((ai * HALF + wr * 64 + m * 16 + fr) * 2 + bj) * 4 + wc] = s;
                    }
            asm volatile("s_waitcnt lgkmcnt(0)" ::: "memory"); __builtin_amdgcn_s_barrier(); asm volatile("" ::: "memory");
            const int gi = (seg == 0) ? 0 : (seg == 1) ? 1 : (seg == 3) ? 2 : 3;
            const PG8_LAS float* gp = gains + gi * 128 + wc * 32 + 8 * fq;
            const f32x4 g0 = *(const PG8_LAS f32x4*)gp, g1 = *(const PG8_LAS f32x4*)(gp + 4);
#pragma unroll
            for (int ai = 0; ai < 2; ++ai)
#pragma unroll
                for (int m = 0; m < 4; ++m) {
                    bf16_t* rowp = O + (size_t)(row0 + ai * HALF + m * 16) * ldc + col0;
#pragma unroll
                    for (int bj = 0; bj < 2; ++bj) {
                        const f32x4 p = *(const PG8_LAS f32x4*)(xch + ((ai * HALF + wr * 64 + m * 16 + fr) * 2 + bj) * 4);
                        const float rs = rsd[ai][m] * __builtin_amdgcn_rsqf(((p[0] + p[1]) + (p[2] + p[3])) * (1.0f / 128.0f) * (rsd[ai][m] * rsd[ai][m]) + 1e-6f);
                        const f32x4 v0 = acc[ai][bj][m][0] * g0 * rs, v1 = acc[ai][bj][m][1] * g1 * rs;
                        u32x4 w; w.x = cvt_pk_bf16(v0[0], v0[1]); w.y = cvt_pk_bf16(v0[2], v0[3]); w.z = cvt_pk_bf16(v1[0], v1[1]); w.w = cvt_pk_bf16(v1[2], v1[3]);
                        *(u32x4*)(rowp + bj * HALF) = w;
                    }
                    asm volatile("" ::: "memory");
                }
        } else {
#pragma unroll
            for (int ai = 0; ai < 2; ++ai)
#pragma unroll
                for (int m = 0; m < 4; ++m) {
                    bf16_t* rowp = O + (size_t)(row0 + ai * HALF + m * 16) * ldc + col0;
#pragma unroll
                    for (int bj = 0; bj < 2; ++bj) {
                        const f32x4 v0 = acc[ai][bj][m][0] * rsd[ai][m], v1 = acc[ai][bj][m][1] * rsd[ai][m];
                        u32x4 w; w.x = cvt_pk_bf16(v0[0], v0[1]); w.y = cvt_pk_bf16(v0[2], v0[3]); w.z = cvt_pk_bf16(v1[0], v1[1]); w.w = cvt_pk_bf16(v1[2], v1[3]);
                        *(u32x4*)(rowp + bj * HALF) = w;
                    }
                }
        }
    }
};

#ifdef PROBE_EPI
#define PG8_EPI_T0() const unsigned long long epi_t0_ = __builtin_amdgcn_s_memrealtime()
#define PG8_EPI_T1() do { atomicAdd((unsigned*)(lds + 131072 + 8192 + 64), (unsigned)(__builtin_amdgcn_s_memrealtime() - epi_t0_)); } while (0)
#else
#define PG8_EPI_T0() do {} while (0)
#define PG8_EPI_T1() do {} while (0)
#endif
template <class Epi, class Sched, bool ALIGN_EPI = false, bool SP2 = false>
__device__ __forceinline__ void gemm_phase(PG8_LAS unsigned char* lds, const Gemm g, const Sched& S, const Epi& E) {
    const int tid = threadIdx.x, wid = __builtin_amdgcn_readfirstlane(tid >> 6), lane = tid & 63, wr = wid >> 2, wc = wid & 3, fr = lane & 15, fq = lane >> 4;
    const int K = g.K, nt = K / BK;
    unsigned voffA[2], voffB[2];
#pragma unroll
    for (int i = 0; i < 2; ++i) { int R, C; stage_rc(tid * 16 + i * 8192, R, C); const int Rb = Epi::PERM ? ((R & ~31) + perm32(R & 31)) : R;
        voffA[i] = (unsigned)(R * K + C) * 2u; voffB[i] = (unsigned)(Rb * K + C) * 2u; }
    const size_t kstep = (size_t)(BK * 2);
    const size_t hstep = (size_t)HALF * K * 2;
    const size_t tstep = 2 * hstep;
    const unsigned ldsw = (unsigned)wid * 1024u;
    const int aoff = lds_byte(wr * 64 + fr, fq * 8), boff = lds_byte(wc * 32 + fr, fq * 8);
#define PG8_SA(b, h) (((b) * 2 + (h)) * HTB)
#define PG8_SB(b, h) ((4 + (b) * 2 + (h)) * HTB)
#define PG8_STAGE(bufoff, gbase, voff) do { _Pragma("unroll") for (int _i = 0; _i < 2; ++_i) \
        __builtin_amdgcn_global_load_lds((const unsigned*)((const char*)(gbase) + (voff)[_i]), (PG8_LAS unsigned*)(lds + (bufoff) + ldsw + _i * 8192), 16, 0, 0); } while (0)
#define PG8_LDA(dst, b, h) do { _Pragma("unroll") for (int m = 0; m < 4; ++m) _Pragma("unroll") for (int k = 0; k < 2; ++k) dst[m][k] = *(const PG8_LAS bf16x8*)(lds + PG8_SA(b, h) + aoff + m * 2048 + k * 1024); } while (0)
#define PG8_LDB(dst, b, h) do { _Pragma("unroll") for (int n = 0; n < 2; ++n) _Pragma("unroll") for (int k = 0; k < 2; ++k) dst[n][k] = *(const PG8_LAS bf16x8*)(lds + PG8_SB(b, h) + boff + n * 2048 + k * 1024); } while (0)
#define PG8_MMA(ai, bj, At, Bt) do { __builtin_amdgcn_s_setprio(1); _Pragma("unroll") for (int m = 0; m < 4; ++m) _Pragma("unroll") for (int n = 0; n < 2; ++n) _Pragma("unroll") for (int k = 0; k < 2; ++k) \
        acc[ai][bj][m][n] = __builtin_amdgcn_mfma_f32_16x16x32_bf16(Bt[n][k], At[m][k], acc[ai][bj][m][n], 0, 0, 0); __builtin_amdgcn_s_setprio(0); } while (0)
#define PG8_WAIT_V(n) asm volatile("s_waitcnt vmcnt(" #n ")" ::: "memory")
#define PG8_WAIT_L(n) asm volatile("s_waitcnt lgkmcnt(" #n ")" ::: "memory")
#define PG8_BAR __builtin_amdgcn_s_barrier()
#define PG8_SCHED __builtin_amdgcn_sched_barrier(0)
    Unit cur, nxt; int ui = 0;
    if (!S.next(0, cur)) return;
    f32x4 acc[2][2][4][2];
#pragma unroll
    for (int a = 0; a < 2; ++a)
#pragma unroll
        for (int b = 0; b < 2; ++b)
#pragma unroll
            for (int m = 0; m < 4; ++m)
#pragma unroll
                for (int n = 0; n < 2; ++n) acc[a][b][m][n] = (f32x4){0.f, 0.f, 0.f, 0.f};
    bf16x8 At[4][2], B0[2][2], B1[2][2];
    const char* cA = (const char*)g.A + (size_t)cur.pm * tstep; const char* cB = (const char*)g.Bt + (size_t)cur.pn * tstep;
    S.a_ready(cur);
    if constexpr (SP2) {
        PG8_STAGE(PG8_SB(0, 0), cB, voffB); PG8_STAGE(PG8_SB(0, 1), cB + hstep, voffB); PG8_STAGE(PG8_SA(0, 0), cA, voffA); PG8_STAGE(PG8_SA(0, 1), cA + hstep, voffA);
        if (wr == 1) PG8_BAR;
        PG8_WAIT_V(2); PG8_BAR;
        PG8_STAGE(PG8_SB(1, 0), cB + kstep, voffB); PG8_STAGE(PG8_SA(1, 0), cA + kstep, voffA); PG8_STAGE(PG8_SB(1, 1), cB + hstep + kstep, voffB);
        PG8_WAIT_V(6); PG8_BAR;
    } else {
        PG8_STAGE(PG8_SB(0, 0), cB, voffB); PG8_STAGE(PG8_SA(0, 0), cA, voffA); PG8_STAGE(PG8_SB(0, 1), cB + hstep, voffB); PG8_STAGE(PG8_SA(0, 1), cA + hstep, voffA);
        if (wr == 1) PG8_BAR;
        PG8_WAIT_V(4); PG8_BAR;
        PG8_STAGE(PG8_SB(1, 0), cB + kstep, voffB); PG8_STAGE(PG8_SA(1, 0), cA + kstep, voffA); PG8_STAGE(PG8_SB(1, 1), cB + hstep + kstep, voffB);
        PG8_WAIT_V(6); PG8_BAR;
    }
    for (;;) {
        const bool has_next = S.next(ui + 1, nxt);
        const char* nA = has_next ? (const char*)g.A + (size_t)nxt.pm * tstep : cA; const char* nB = has_next ? (const char*)g.Bt + (size_t)nxt.pn * tstep : cB;
        for (int t = 0; t < nt; t += 2) {
            const bool last = (t == nt - 2);
            const char* a1 = cA + (size_t)(t + 1) * kstep;
            const char* a2 = last ? nA : cA + (size_t)(t + 2) * kstep; const char* b2 = last ? nB : cB + (size_t)(t + 2) * kstep;
            const char* a3 = a2 + kstep; const char* b3 = b2 + kstep;
            if (last && has_next) S.a_ready(nxt);
            if constexpr (SP2) {
            PG8_LDB(B0, 0, 0); PG8_LDB(B1, 0, 1); PG8_SCHED; PG8_LDA(At, 0, 0); PG8_STAGE(PG8_SA(1, 1), a1 + hstep, voffA);
            PG8_WAIT_V(8); PG8_WAIT_L(0); PG8_BAR; PG8_MMA(0, 0, At, B0); PG8_MMA(0, 1, At, B1); PG8_BAR; PG8_SCHED;
            PG8_LDA(At, 0, 1); PG8_STAGE(PG8_SB(0, 0), b2, voffB); PG8_STAGE(PG8_SB(0, 1), b2 + hstep, voffB); PG8_STAGE(PG8_SA(0, 0), a2, voffA);
            PG8_WAIT_V(8); PG8_WAIT_L(0); PG8_BAR; PG8_MMA(1, 0, At, B0); PG8_MMA(1, 1, At, B1); PG8_BAR; PG8_SCHED;
            PG8_LDB(B0, 1, 0); PG8_LDB(B1, 1, 1); PG8_SCHED; PG8_LDA(At, 1, 0); PG8_STAGE(PG8_SA(0, 1), a2 + hstep, voffA);
            PG8_WAIT_V(8); PG8_WAIT_L(0); PG8_BAR; PG8_MMA(0, 0, At, B0); PG8_MMA(0, 1, At, B1); PG8_BAR; PG8_SCHED;
            PG8_LDA(At, 1, 1); PG8_STAGE(PG8_SB(1, 0), b3, voffB); PG8_STAGE(PG8_SB(1, 1), b3 + hstep, voffB); PG8_STAGE(PG8_SA(1, 0), a3, voffA);
            PG8_WAIT_V(8); PG8_WAIT_L(0); PG8_BAR; PG8_MMA(1, 0, At, B0); PG8_MMA(1, 1, At, B1); PG8_BAR; PG8_SCHED;
            } else {
            PG8_LDB(B0, 0, 0); PG8_SCHED; PG8_LDA(At, 0, 0); PG8_STAGE(PG8_SA(1, 1), a1 + hstep, voffA);
            PG8_WAIT_L(8); PG8_BAR; PG8_WAIT_L(0); PG8_MMA(0, 0, At, B0); PG8_BAR; PG8_SCHED;
            PG8_LDB(B1, 0, 1); PG8_STAGE(PG8_SB(0, 0), b2, voffB);
            PG8_BAR; PG8_WAIT_L(0); PG8_MMA(0, 1, At, B1); PG8_BAR;
            PG8_LDA(At, 0, 1); PG8_STAGE(PG8_SA(0, 0), a2, voffA);
            PG8_BAR; PG8_WAIT_L(0); PG8_MMA(1, 0, At, B0); PG8_BAR; PG8_SCHED;
            PG8_STAGE(PG8_SB(0, 1), b2 + hstep, voffB);
            PG8_WAIT_V(6); PG8_BAR; PG8_MMA(1, 1, At, B1); PG8_BAR;
            PG8_LDB(B0, 1, 0); PG8_SCHED; PG8_LDA(At, 1, 0); PG8_STAGE(PG8_SA(0, 1), a2 + hstep, voffA);
            PG8_WAIT_L(8); PG8_BAR; PG8_WAIT_L(0); PG8_MMA(0, 0, At, B0); PG8_BAR; PG8_SCHED;
            PG8_LDB(B1, 1, 1); PG8_STAGE(PG8_SB(1, 0), b3, voffB);
            PG8_BAR; PG8_WAIT_L(0); PG8_MMA(0, 1, At, B1); PG8_BAR;
            PG8_LDA(At, 1, 1); PG8_STAGE(PG8_SA(1, 0), a3, voffA);
            PG8_BAR; PG8_WAIT_L(0); PG8_MMA(1, 0, At, B0); PG8_BAR; PG8_SCHED;
            PG8_STAGE(PG8_SB(1, 1), b3 + hstep, voffB);
            PG8_WAIT_V(6); PG8_BAR; PG8_MMA(1, 1, At, B1); PG8_BAR;
            }
        }
        if constexpr (ALIGN_EPI) { if (wr == 0) PG8_BAR; }
        if constexpr (!Epi::AFTER_DRAIN) { PG8_EPI_T0(); E(acc, cur, wr, wc, fr, fq); PG8_EPI_T1(); S.done(cur); }
        if (!has_next) break;
#pragma unroll
        for (int a = 0; a < 2; ++a)
#pragma unroll
            for (int b = 0; b < 2; ++b)
#pragma unroll
                for (int m = 0; m < 4; ++m)
#pragma unroll
                    for (int n = 0; n < 2; ++n) acc[a][b][m][n] = (f32x4){0.f, 0.f, 0.f, 0.f};
        cur = nxt; cA = nA; cB = nB; ++ui;
        if constexpr (ALIGN_EPI) { if (wr == 1) PG8_BAR; }
    }
    PG8_WAIT_V(0);
    if constexpr (!ALIGN_EPI) { if (wr == 0) PG8_BAR; }
    PG8_BAR;
    if constexpr (Epi::AFTER_DRAIN) { E.fused(acc, cur, wr, wc, fr, fq, lds, wid, lane); S.done(cur); }
#undef PG8_SA
#undef PG8_SB
#undef PG8_STAGE
#undef PG8_LDA
#undef PG8_LDB
#undef PG8_MMA
#undef PG8_WAIT_V
#undef PG8_WAIT_L
#undef PG8_BAR
#undef PG8_SCHED
}

}

namespace att {
typedef unsigned short bf16;
typedef short bf16x8 __attribute__((ext_vector_type(8)));
typedef short s16x4 __attribute__((ext_vector_type(4)));
typedef float f32x16 __attribute__((ext_vector_type(16)));
typedef float f32x4 __attribute__((ext_vector_type(4)));
typedef unsigned u32x4 __attribute__((ext_vector_type(4)));
constexpr float SCALE = 0.08838834764831845f, INV_SCALE = 11.313708498984761f, THR = 8.f;
constexpr float C2 = 1.4426950408889634f * SCALE;
constexpr int NW = 8, QBLK = 32, KVBLK = 64, QB = NW * QBLK, D = 128;
constexpr int SHM_V = KVBLK * D * 2, SHM_K = KVBLK * D * 2;
constexpr int NBUF = 3, L_K = 0, L_V = NBUF * SHM_K, L_WS = L_V + NBUF * SHM_V, L_TB = L_WS + NW * 64 * 4, TB_N = 352, TB_PAD = 96, L_CB = L_TB + TB_N * 4, L_WT = L_CB + 4096 * 4, L_END = L_WT + 64;
static_assert(L_END <= 131072 && (L_CB % 16) == 0, "attention LDS map");

#define KSWZ(row, colB) ((row) * 256 + ((colB) ^ (((row) & 7) << 4)))
#define SBAR() __builtin_amdgcn_sched_barrier(0)
__device__ __forceinline__ int v_st(int k, int c) { const int kk = (k & ~0xC) | ((k & 4) << 1) | ((k & 8) >> 1); return ((kk >> 3) * 4 + (c >> 5)) * 512 + ((kk & 7) * 32 + (c & 31)) * 2; }
__device__ __forceinline__ int v_rd_base(int lane) { return ((lane & 3) << 3) | (((lane >> 2) & 3) << 6) | (((lane >> 4) & 1) << 5) | (((lane >> 5) & 1) << 8); }
constexpr int v_rd_off(int d0, int ks, int half) { return d0 * 512 + ks * 4096 + half * 2048; }
__device__ __forceinline__ int crow(int r, int hi) { return (r & 3) + 8 * (r >> 2) + 4 * hi; }
__device__ __forceinline__ unsigned cvtpk(float lo, float hi) { unsigned r; asm volatile("v_cvt_pk_bf16_f32 %0, %1, %2" : "=v"(r) : "v"(lo), "v"(hi)); return r; }
__device__ __forceinline__ void mask_tile(f32x16& p0, f32x16& p1, int dq, unsigned W) {
    const float NEG = -__builtin_inff();
#pragma unroll
    for (int r = 0; r < 16; ++r) {
        const int c = (r & 3) + 8 * (r >> 2);
        if ((unsigned)(dq - c) >= W) p0[r] = NEG;
        if ((unsigned)(dq - c - 32) >= W) p1[r] = NEG;
    }
}
__device__ __forceinline__ void partialSM(f32x16& p0, f32x16& p1, float& m_reg, float& mn, float& alpha) {
    float pmax = p0[0];
#pragma unroll
    for (int r = 1; r < 16; ++r) pmax = fmaxf(pmax, p0[r]);
#pragma unroll
    for (int r = 0; r < 16; ++r) pmax = fmaxf(pmax, p1[r]);
    { auto rr = __builtin_amdgcn_permlane32_swap(__float_as_uint(pmax), __float_as_uint(pmax), false, false);
      pmax = fmaxf(__uint_as_float(rr[0]), __uint_as_float(rr[1])); }
    if (__builtin_expect(__all((pmax - m_reg) * SCALE <= THR), 1)) { mn = m_reg; alpha = 1.f; }
    else { mn = fmaxf(m_reg, pmax); alpha = __builtin_amdgcn_exp2f((m_reg - mn) * C2); m_reg = mn; }
    const float mnL = -mn * C2;
#pragma unroll
    for (int r = 0; r < 16; ++r) p0[r] = fmaf(p0[r], C2, mnL);
#pragma unroll
    for (int r = 0; r < 16; ++r) p1[r] = fmaf(p1[r], C2, mnL);
#pragma unroll
    for (int r = 0; r < 16; ++r) p0[r] = __builtin_amdgcn_exp2f(p0[r]);
}
__device__ __forceinline__ void finishSM(f32x16& p0, f32x16& p1, float alpha, float& l_reg, bf16x8& pa0, bf16x8& pa1, bf16x8& pa2, bf16x8& pa3) {
#pragma unroll
    for (int r = 0; r < 16; ++r) p1[r] = __builtin_amdgcn_exp2f(p1[r]);
    float ps = 0;
#pragma unroll
    for (int r = 0; r < 16; ++r) ps += p0[r];
#pragma unroll
    for (int r = 0; r < 16; ++r) ps += p1[r];
    { auto rr = __builtin_amdgcn_permlane32_swap(__float_as_uint(ps), __float_as_uint(ps), false, false);
      ps = __uint_as_float(rr[0]) + __uint_as_float(rr[1]); }
    l_reg = l_reg * alpha + ps;
#define PK4(P, B_, OUT) do { unsigned a0 = cvtpk(P[B_+0], P[B_+1]), a1 = cvtpk(P[B_+2], P[B_+3]);                          \
        unsigned b0 = cvtpk(P[B_+4], P[B_+5]), b1 = cvtpk(P[B_+6], P[B_+7]);                                             \
        auto r0 = __builtin_amdgcn_permlane32_swap(a0, b0, false, false); auto r1 = __builtin_amdgcn_permlane32_swap(a1, b1, false, false); \
        u32x4 w = {r0[0], r1[0], r0[1], r1[1]}; OUT = *reinterpret_cast<bf16x8*>(&w); } while (0)
    PK4(p0, 0, pa0); PK4(p0, 8, pa1); PK4(p1, 0, pa2); PK4(p1, 8, pa3);
#undef PK4
}
#define ALAS __attribute__((address_space(3)))
__device__ __forceinline__ void qkt(f32x16& p0, f32x16& p1, const ALAS char* Kb, int r32, int hi, const bf16x8* qr) {
    const ALAS char* kb[4];
#pragma unroll
    for (int dd = 0; dd < 4; ++dd) kb[dd] = Kb + KSWZ(r32, (dd * 16 + hi * 8) * 2);
#pragma unroll
    for (int d0 = 0; d0 < 8; ++d0) { const ALAS char* a = kb[d0 & 3] + (d0 >> 2) * 128;
        bf16x8 b0 = *reinterpret_cast<const ALAS bf16x8*>(a);
        bf16x8 b1 = *reinterpret_cast<const ALAS bf16x8*>(a + 32 * 256);
        p0 = __builtin_amdgcn_mfma_f32_32x32x16_bf16(b0, qr[d0], p0, 0, 0, 0);
        p1 = __builtin_amdgcn_mfma_f32_32x32x16_bf16(b1, qr[d0], p1, 0, 0, 0); }
}
__device__ __forceinline__ void pv_tile(f32x16* o, int vb, bf16x8 pa0, bf16x8 pa1, bf16x8 pa2, bf16x8 pa3) {
#define TRRD(dst, off) asm volatile("ds_read_b64_tr_b16 %0, %1 offset:%2" : "=&v"(dst) : "v"(vb), "i"(off) : "memory")
#define PV_D0(d0) do { s16x4 l0, l1, l2, l3, h0, h1, h2, h3; constexpr int b_ = v_rd_off(d0, 0, 0); \
        TRRD(l0, b_); TRRD(h0, b_ + 2048); TRRD(l1, b_ + 4096); TRRD(h1, b_ + 6144); TRRD(l2, b_ + 8192); TRRD(h2, b_ + 10240); TRRD(l3, b_ + 12288); TRRD(h3, b_ + 14336); \
        asm volatile("s_waitcnt lgkmcnt(0)" ::: "memory"); SBAR();   \
        o[d0] = __builtin_amdgcn_mfma_f32_32x32x16_bf16(pa0, (bf16x8){l0[0], l0[1], l0[2], l0[3], h0[0], h0[1], h0[2], h0[3]}, o[d0], 0, 0, 0);   \
        o[d0] = __builtin_amdgcn_mfma_f32_32x32x16_bf16(pa1, (bf16x8){l1[0], l1[1], l1[2], l1[3], h1[0], h1[1], h1[2], h1[3]}, o[d0], 0, 0, 0);   \
        o[d0] = __builtin_amdgcn_mfma_f32_32x32x16_bf16(pa2, (bf16x8){l2[0], l2[1], l2[2], l2[3], h2[0], h2[1], h2[2], h2[3]}, o[d0], 0, 0, 0);   \
        o[d0] = __builtin_amdgcn_mfma_f32_32x32x16_bf16(pa3, (bf16x8){l3[0], l3[1], l3[2], l3[3], h3[0], h3[1], h3[2], h3[3]}, o[d0], 0, 0, 0); } while (0)
    PV_D0(0); PV_D0(1); PV_D0(2); PV_D0(3);
#undef PV_D0
#undef TRRD
}

struct UnitD {
    const bf16* Q; const bf16* K; const bf16* V; int pitch;
    bf16* O; int opitch;
    float* den; float* mx; int spitch;
    const float* lf;
    const float* rel; int head; int dil;
    int q0, jlo, jhi; int W;
    float skip_thr;
};

template <bool FOX>
__device__ __forceinline__ void attn_unit(const UnitD& U, ALAS char* lds, unsigned* qctr, unsigned& nxt_id) {
    int tid_ = threadIdx.x; asm volatile("" : "+v"(tid_));
    const int tid = tid_, wid = __builtin_amdgcn_readfirstlane(tid >> 6), lane = tid & 63, r32 = lane & 31, hi = lane >> 5;
    constexpr bool fox = FOX;
    int NT = U.jhi - U.jlo;
    const int qlo = U.q0 + wid * QBLK, qm = qlo + r32 - 4 * hi;
    const int W = U.W;
    ALAS char* K_lds = lds + L_K; ALAS char* V_lds = lds + L_V;
    ALAS float* wsl = (ALAS float*)(lds + L_WS) + wid * 64; ALAS float* li_l = wsl; ALAS float* al_l = wsl + 32;
    ALAS float* cbl = (ALAS float*)(lds + L_CB); ALAS float* Tl = (ALAS float*)(lds + L_TB);
    const int vb0 = (int)(unsigned)(uintptr_t)V_lds + v_rd_base(lane);
    int koff[2], voff[2];
#pragma unroll
    for (int i = 0; i < 2; ++i) {
        const int L = (wid * 2 + i) * 64 + lane;
        { const int r = L >> 4, c = (L & 15) ^ (r & 7); koff[i] = r * U.pitch + c * 8; }
        { const int o = L * 16, sub = o >> 9, kkhi = sub >> 2, cblk = sub & 3, w16 = (o & 511) >> 1, kk = kkhi * 8 + (w16 >> 5), cc = cblk * 32 + (w16 & 31);
          const int k = (kk & ~0xC) | ((kk & 4) << 1) | ((kk & 8) >> 1); voff[i] = k * U.pitch + cc; }
    }
#define DMA_K(kb_, buf_) do { const bf16* kg_ = U.K + (size_t)(kb_) * U.pitch;                                                              \
        _Pragma("unroll") for (int i_ = 0; i_ < 2; ++i_)                                                                                 \
            __builtin_amdgcn_global_load_lds((const unsigned*)(kg_ + koff[i_]), (ALAS unsigned*)(K_lds + (buf_) * SHM_K + (wid * 2 + i_) * 1024), 16, 0, 0); } while (0)
#define DMA_V(kb_, buf_) do { const bf16* vg_ = U.V + (size_t)(kb_) * U.pitch;                                                              \
        _Pragma("unroll") for (int i_ = 0; i_ < 2; ++i_)                                                                                 \
            __builtin_amdgcn_global_load_lds((const unsigned*)(vg_ + voff[i_]), (ALAS unsigned*)(V_lds + (buf_) * SHM_V + (wid * 2 + i_) * 1024), 16, 0, 0); } while (0)
#define KB_(it_) ((U.jhi - 1 - (it_)) * KVBLK)
    bf16x8 qr[8];
    { const bf16* qp = U.Q + (size_t)(qlo + r32) * U.pitch + hi * 8;
#pragma unroll
      for (int d0 = 0; d0 < 8; ++d0) qr[d0] = *(const bf16x8*)(qp + d0 * 16); }
    DMA_K(KB_(0), 0); DMA_V(KB_(0), 0);
    if (NT > 1) DMA_K(KB_(1), 1);
    float cqs = 0.f;
    const int s0 = U.jlo * KVBLK;
    if (fox) {
        const int n = U.q0 + QB - s0, t0 = tid * 8; float v[8]; float s8 = 0.f;
        if (t0 < n) { const f32x4 a0 = *(const f32x4*)(U.lf + s0 + t0), a1 = *(const f32x4*)(U.lf + s0 + t0 + 4);
            v[0] = a0[0]; v[1] = a0[1]; v[2] = a0[2]; v[3] = a0[3]; v[4] = a1[0]; v[5] = a1[1]; v[6] = a1[2]; v[7] = a1[3]; }
        else {
#pragma unroll
            for (int i = 0; i < 8; ++i) v[i] = 0.f; }
#pragma unroll
        for (int i = 0; i < 8; ++i) s8 += v[i];
        float incl = s8;
#pragma unroll
        for (int o = 1; o < 64; o <<= 1) { const float t = __shfl_up(incl, o); if (lane >= o) incl += t; }
        ALAS float* wtot = (ALAS float*)(lds + L_WT);
        if (lane == 63) wtot[wid] = incl;
        __syncthreads();
        float run = incl - s8;
        for (int w = 0; w < wid; ++w) run += wtot[w];
        if (t0 < n) {
#pragma unroll
            for (int i = 0; i < 8; ++i) { run += v[i]; cbl[t0 + i] = -run * INV_SCALE; } }
    } else {
        if (tid < TB_N) Tl[tid] = U.rel[tid];
    }
    float m_reg = -1e30f, l_reg = 0.f; f32x16 o[4];
#pragma unroll
    for (int d = 0; d < 4; ++d)
#pragma unroll
        for (int r = 0; r < 16; ++r) o[d][r] = 0.f;
    asm volatile("s_waitcnt vmcnt(0)" ::: "memory");
    __syncthreads();
    if (fox) {
        cqs = -cbl[qlo + r32 - s0];
        bool ns = false;
        if (lane < NT) { const int kbt = (U.jhi - 1 - lane) * KVBLK; ns = (kbt + KVBLK - 1 >= U.q0) || (cbl[kbt + KVBLK - 1 - s0] - cbl[U.q0 - s0] >= U.skip_thr); }
        const unsigned long long mk = __ballot(ns);
        NT = __builtin_amdgcn_readfirstlane(64 - __builtin_clzll(mk | 1ull));
    }
#define ACT_(kb_) (FOX || ((kb_) <= qlo + QBLK - 1 && (kb_) + KVBLK - 1 >= qlo - W + 1))
#define QK(P0_, P1_, it_, buf_) do { const int kb_ = KB_(it_);                                                                           \
        if (ACT_(kb_)) {                                                                                                                \
            if (fox) { const ALAS float* ck_ = cbl + (kb_ - s0) + 4 * hi;                                                                      \
                _Pragma("unroll") for (int g = 0; g < 4; ++g) { const f32x4 a_ = *(const ALAS f32x4*)(ck_ + 8 * g), b_ = *(const ALAS f32x4*)(ck_ + 32 + 8 * g);   \
                    _Pragma("unroll") for (int e = 0; e < 4; ++e) { P0_[4 * g + e] = cqs + a_[e]; P1_[4 * g + e] = cqs + b_[e]; } } }   \
            else { const ALAS float* tb_ = Tl + (TB_PAD - 59) + (qm - kb_);                                                             \
                _Pragma("unroll") for (int r = 0; r < 16; ++r) { const int c_ = (r & 3) + 8 * (r >> 2); P0_[r] = tb_[59 - c_]; P1_[r] = tb_[27 - c_]; } }  \
            qkt(P0_, P1_, K_lds + (buf_) * SHM_K, r32, hi, qr);                                                                         \
        } else { const float NEG_ = -__builtin_inff(); _Pragma("unroll") for (int r = 0; r < 16; ++r) { P0_[r] = NEG_; P1_[r] = NEG_; } } } while (0)
#define MASKT(P0_, P1_, it_) do { const int kb_ = KB_(it_);                                                                              \
        if (ACT_(kb_) && (kb_ + KVBLK - 1 > qlo || kb_ <= qlo + QBLK - 1 - W)) mask_tile(P0_, P1_, qm - kb_, (unsigned)W); } while (0)
#define PV(it_, buf_) do { if (ACT_(KB_(it_))) pv_tile(o, vb0 + (buf_) * SHM_V, pa0, pa1, pa2, pa3); } while (0)
#define RESC(a_) do { if (__any((a_) < 1.f)) { if (hi == 0) al_l[r32] = (a_); asm volatile("s_waitcnt lgkmcnt(0)" ::: "memory"); const ALAS float* alh_ = al_l + 4 * hi;  \
        _Pragma("unroll") for (int d_ = 0; d_ < 4; ++d_) _Pragma("unroll") for (int r = 0; r < 16; ++r) o[d_][r] *= alh_[(r & 3) + 8 * (r >> 2)]; } } while (0)
#ifdef PROBE_ATT
    const unsigned long long tl0_ = __builtin_amdgcn_s_memrealtime();
#endif
    f32x16 pA0, pA1, pB0, pB1; float mnA, mnB, alA, alB; bf16x8 pa0, pa1, pa2, pa3;
#define STEP_END(t_) do { if ((t_) + 2 < NT) asm volatile("s_waitcnt vmcnt(4)" ::: "memory"); else asm volatile("s_waitcnt vmcnt(0)" ::: "memory");   \
        asm volatile("s_waitcnt lgkmcnt(0)" ::: "memory"); __builtin_amdgcn_s_barrier(); asm volatile("" ::: "memory"); } while (0)
    if (NT > 2) DMA_K(KB_(2), 2);
    if (NT > 1) DMA_V(KB_(1), 1);
    QK(pA0, pA1, 0, 0); MASKT(pA0, pA1, 0); partialSM(pA0, pA1, m_reg, mnA, alA);
    STEP_END(0);
#define HALF(PX0, PX1, mnX, alX, PY0, PY1, alY, t_, bx_, by_, bn_) do {                                                                  \
        if ((t_) + 2 < NT) DMA_K(KB_((t_) + 2), by_);                                                                                  \
        if ((t_) + 1 < NT) DMA_V(KB_((t_) + 1), bn_);                                                                                  \
        SBAR(); QK(PX0, PX1, t_, bx_);                                                                                                  \
        finishSM(PY0, PY1, alY, l_reg, pa0, pa1, pa2, pa3); SBAR();                                                                     \
        PV((t_) - 1, by_); MASKT(PX0, PX1, t_); partialSM(PX0, PX1, m_reg, mnX, alX);                                                   \
        RESC(alX);                                                                                                                      \
        STEP_END(t_); } while (0)
    int t = 1, b0 = 0, b1 = 1, b2 = 2;
    for (; t + 1 < NT; t += 2) {
        HALF(pB0, pB1, mnB, alB, pA0, pA1, alA, t, b1, b0, b2);
        HALF(pA0, pA1, mnA, alA, pB0, pB1, alB, t + 1, b2, b1, b0);
        { const int n0 = b2, n1 = b0, n2 = b1; b0 = n0; b1 = n1; b2 = n2; }
    }
    int bl = b0;
    if ((NT & 1) == 0) {
        SBAR(); QK(pB0, pB1, NT - 1, b1);
        finishSM(pA0, pA1, alA, l_reg, pa0, pa1, pa2, pa3); SBAR();
        PV(NT - 2, b0); MASKT(pB0, pB1, NT - 1); partialSM(pB0, pB1, m_reg, mnB, alB);
        RESC(alB);
        pA0 = pB0; pA1 = pB1; alA = alB; bl = b1;
    }
    finishSM(pA0, pA1, alA, l_reg, pa0, pa1, pa2, pa3); SBAR();
    PV(NT - 1, bl);
#undef HALF
#undef RESC
#undef PV
#undef MASKT
#undef QK
#undef ACT_
#undef KB_
#undef DMA_K
#undef DMA_V
#undef STEP_END
#ifdef PROBE_ATT
    if (tid == 0) *(volatile ALAS unsigned*)(lds + 131072 + 8192 + 68) += (unsigned)(__builtin_amdgcn_s_memrealtime() - tl0_);
#endif
    if (tid == 0) nxt_id = atomicAdd(qctr, 1u);
    if (hi == 0) li_l[r32] = l_reg;
    asm volatile("s_waitcnt lgkmcnt(0)" ::: "memory");
    float rli[16];
    { const ALAS float* lih = li_l + 4 * hi;
#pragma unroll
    for (int r = 0; r < 16; ++r) rli[r] = __builtin_amdgcn_rcpf(lih[(r & 3) + 8 * (r >> 2)]); }
    __syncthreads();
    { ALAS float* St = (ALAS float*)(lds + wid * 8192);
      const int rr8 = lane >> 3, c8 = lane & 7;
#pragma unroll
      for (int hf = 0; hf < 2; ++hf) {
#pragma unroll
          for (int r = 0; r < 16; ++r) { const int orow = (r & 3) + 8 * (r >> 2) + 4 * hi;
#pragma unroll
              for (int dd = 0; dd < 2; ++dd) St[orow * 64 + dd * 32 + r32] = o[hf * 2 + dd][r] * rli[r]; }
          asm volatile("s_waitcnt lgkmcnt(0)" ::: "memory");
          bf16* Ow = U.O + (size_t)qlo * U.opitch + hf * 64 + c8 * 8;
#pragma unroll
          for (int j = 0; j < 4; ++j) { const int row = 8 * j + rr8;
              const f32x4 a0 = *(const ALAS f32x4*)(St + row * 64 + c8 * 8), a1 = *(const ALAS f32x4*)(St + row * 64 + c8 * 8 + 4);
              u32x4 w = {cvtpk(a0[0], a0[1]), cvtpk(a0[2], a0[3]), cvtpk(a1[0], a1[1]), cvtpk(a1[2], a1[3])};
              *(u32x4*)(Ow + (size_t)row * U.opitch) = w; }
          asm volatile("s_waitcnt lgkmcnt(0)" ::: "memory");
      } }
    if (U.den != nullptr && hi == 0) { U.den[(size_t)(qlo + r32) * U.spitch] = l_reg; U.mx[(size_t)(qlo + r32) * U.spitch] = m_reg; }
}

constexpr int D_WS = 131072, D_TB = D_WS + NW * 64 * 4;
__device__ __forceinline__ void attn_unit_dil(const UnitD& U, ALAS char* lds, unsigned* qctr, unsigned& nxt_id) {
    int tid_ = threadIdx.x; asm volatile("" : "+v"(tid_));
    const int tid = tid_, wid = __builtin_amdgcn_readfirstlane(tid >> 6), lane = tid & 63, r32 = lane & 31, hi = lane >> 5;
    const int qlo = U.q0 + wid * QBLK, qm = qlo + r32 - 4 * hi;
    const int NT = (qlo >> 5) + 1 < 5 ? (qlo >> 5) + 1 : 5;
    ALAS char* Kb = lds + wid * 16384; ALAS char* Vb = Kb + 8192;
    ALAS float* wsl = (ALAS float*)(lds + D_WS) + wid * 64; ALAS float* li_l = wsl; ALAS float* al_l = wsl + 32;
    ALAS float* Tl = (ALAS float*)(lds + D_TB);
    const int vb = (int)(unsigned)(uintptr_t)Vb + v_rd_base(lane);
    const int g4 = lane >> 4, c16 = lane & 15;
    const int koffE = g4 * U.pitch + ((c16 ^ g4) << 3), koffO = g4 * U.pitch + ((c16 ^ (4 + g4)) << 3);
    const int kklo = (lane & 31) >> 2, voffL = (8 * (kklo >> 2) + (kklo & 3)) * U.pitch + (lane >> 5) * 32 + ((lane & 3) << 3);
#define DMA_K32(kb_) do { const bf16* kg_ = U.K + (size_t)(kb_) * U.pitch;                                                                  \
        _Pragma("unroll") for (int i_ = 0; i_ < 8; ++i_)                                                                                  \
            __builtin_amdgcn_global_load_lds((const unsigned*)(kg_ + (size_t)(4 * i_) * U.pitch + ((i_ & 1) ? koffO : koffE)), (ALAS unsigned*)(Kb + i_ * 1024), 16, 0, 0); } while (0)
#define DMA_V32(kb_) do { const bf16* vg_ = U.V + (size_t)(kb_) * U.pitch;                                                                  \
        _Pragma("unroll") for (int i_ = 0; i_ < 8; ++i_)                                                                                  \
            __builtin_amdgcn_global_load_lds((const unsigned*)(vg_ + (size_t)(16 * (i_ >> 2) + 4 * ((i_ >> 1) & 1)) * U.pitch + 64 * (i_ & 1) + voffL), (ALAS unsigned*)(Vb + i_ * 1024), 16, 0, 0); } while (0)
    bf16x8 qr[8];
    { const bf16* qp = U.Q + (size_t)(qlo + r32) * U.pitch + hi * 8;
#pragma unroll
      for (int d0 = 0; d0 < 8; ++d0) qr[d0] = *(const bf16x8*)(qp + d0 * 16); }
    DMA_K32(qlo); DMA_V32(qlo);
    if (tid < TB_N) Tl[tid] = U.rel[tid];
    float m_reg = -1e30f, l_reg = 0.f; f32x16 o[4];
#pragma unroll
    for (int d = 0; d < 4; ++d)
#pragma unroll
        for (int r = 0; r < 16; ++r) o[d][r] = 0.f;
    asm volatile("s_waitcnt vmcnt(0)" ::: "memory");
    __syncthreads();
    for (int t = 0; t < NT; ++t) {
        const int kb = qlo - 32 * t; const bool more = t + 1 < NT;
        f32x16 p0;
        { const ALAS float* tb_ = Tl + (TB_PAD - 59) + (qm - kb);
#pragma unroll
          for (int r = 0; r < 16; ++r) { const int c_ = (r & 3) + 8 * (r >> 2); p0[r] = tb_[59 - c_]; } }
        { const ALAS char* kbp[4];
#pragma unroll
          for (int dd = 0; dd < 4; ++dd) kbp[dd] = Kb + KSWZ(r32, (dd * 16 + hi * 8) * 2);
#pragma unroll
          for (int d0 = 0; d0 < 8; ++d0) { const bf16x8 b0 = *reinterpret_cast<const ALAS bf16x8*>(kbp[d0 & 3] + (d0 >> 2) * 128);
              p0 = __builtin_amdgcn_mfma_f32_32x32x16_bf16(b0, qr[d0], p0, 0, 0, 0); } }
        asm volatile("" ::: "memory"); SBAR();
        if (more) DMA_K32(kb - 32);
        SBAR();
        if (t == 0 || kb == qlo - 128) { const float NEG = -__builtin_inff(); const int dq = qm - kb;
#pragma unroll
            for (int r = 0; r < 16; ++r) { const int c = (r & 3) + 8 * (r >> 2); if ((unsigned)(dq - c) >= 129u) p0[r] = NEG; } }
        float pmax = p0[0];
#pragma unroll
        for (int r = 1; r < 16; ++r) pmax = fmaxf(pmax, p0[r]);
        { auto rr = __builtin_amdgcn_permlane32_swap(__float_as_uint(pmax), __float_as_uint(pmax), false, false);
          pmax = fmaxf(__uint_as_float(rr[0]), __uint_as_float(rr[1])); }
        float mn, alpha;
        if (__builtin_expect(__all((pmax - m_reg) * SCALE <= THR), 1)) { mn = m_reg; alpha = 1.f; }
        else { mn = fmaxf(m_reg, pmax); alpha = __builtin_amdgcn_exp2f((m_reg - mn) * C2); m_reg = mn; }
        const float mnL = -mn * C2; float ps = 0.f;
#pragma unroll
        for (int r = 0; r < 16; ++r) { p0[r] = __builtin_amdgcn_exp2f(fmaf(p0[r], C2, mnL)); ps += p0[r]; }
        { auto rr = __builtin_amdgcn_permlane32_swap(__float_as_uint(ps), __float_as_uint(ps), false, false);
          ps = __uint_as_float(rr[0]) + __uint_as_float(rr[1]); }
        l_reg = l_reg * alpha + ps;
        if (__any(alpha < 1.f)) { if (hi == 0) al_l[r32] = alpha; asm volatile("s_waitcnt lgkmcnt(0)" ::: "memory"); const ALAS float* alh_ = al_l + 4 * hi;
#pragma unroll
            for (int d_ = 0; d_ < 4; ++d_)
#pragma unroll
                for (int r = 0; r < 16; ++r) o[d_][r] *= alh_[(r & 3) + 8 * (r >> 2)]; }
        bf16x8 pa0, pa1;
#define PK4(P, B_, OUT) do { unsigned a0 = cvtpk(P[B_+0], P[B_+1]), a1 = cvtpk(P[B_+2], P[B_+3]);                          \
        unsigned b0 = cvtpk(P[B_+4], P[B_+5]), b1 = cvtpk(P[B_+6], P[B_+7]);                                             \
        auto r0 = __builtin_amdgcn_permlane32_swap(a0, b0, false, false); auto r1 = __builtin_amdgcn_permlane32_swap(a1, b1, false, false); \
        u32x4 w = {r0[0], r1[0], r0[1], r1[1]}; OUT = *reinterpret_cast<bf16x8*>(&w); } while (0)
        PK4(p0, 0, pa0); PK4(p0, 8, pa1);
#undef PK4
        if (more) asm volatile("s_waitcnt vmcnt(8)" ::: "memory"); else asm volatile("s_waitcnt vmcnt(0)" ::: "memory");
        SBAR();
#define TRRD(dst, off) asm volatile("ds_read_b64_tr_b16 %0, %1 offset:%2" : "=&v"(dst) : "v"(vb), "i"(off) : "memory")
#define PV_D0(d0) do { s16x4 l0, l1, h0, h1; constexpr int b_ = v_rd_off(d0, 0, 0); TRRD(l0, b_); TRRD(h0, b_ + 2048); TRRD(l1, b_ + 4096); TRRD(h1, b_ + 6144); \
        asm volatile("s_waitcnt lgkmcnt(0)" ::: "memory"); SBAR();   \
        o[d0] = __builtin_amdgcn_mfma_f32_32x32x16_bf16(pa0, (bf16x8){l0[0], l0[1], l0[2], l0[3], h0[0], h0[1], h0[2], h0[3]}, o[d0], 0, 0, 0);   \
        o[d0] = __builtin_amdgcn_mfma_f32_32x32x16_bf16(pa1, (bf16x8){l1[0], l1[1], l1[2], l1[3], h1[0], h1[1], h1[2], h1[3]}, o[d0], 0, 0, 0); } while (0)
        PV_D0(0); PV_D0(1); PV_D0(2); PV_D0(3);
#undef PV_D0
#undef TRRD
        asm volatile("" ::: "memory"); SBAR();
        if (more) { DMA_V32(kb - 32);
            asm volatile("s_waitcnt vmcnt(8)" ::: "memory"); SBAR(); }
    }
#undef DMA_K32
#undef DMA_V32
    if (tid == 0) nxt_id = atomicAdd(qctr, 1u);
    if (hi == 0) li_l[r32] = l_reg;
    asm volatile("s_waitcnt lgkmcnt(0)" ::: "memory");
    float rli[16];
    { const ALAS float* lih = li_l + 4 * hi;
#pragma unroll
    for (int r = 0; r < 16; ++r) rli[r] = __builtin_amdgcn_rcpf(lih[(r & 3) + 8 * (r >> 2)]); }
    { ALAS float* St = (ALAS float*)Kb;
#pragma unroll
      for (int r = 0; r < 16; ++r) { const int orow = (r & 3) + 8 * (r >> 2) + 4 * hi;
#pragma unroll
          for (int d0 = 0; d0 < 4; ++d0) St[orow * 128 + d0 * 32 + r32] = o[d0][r] * rli[r]; }
      asm volatile("s_waitcnt lgkmcnt(0)" ::: "memory");
      bf16* Ow = U.O + (size_t)qlo * U.opitch + c16 * 8;
#pragma unroll
      for (int j = 0; j < 8; ++j) { const int row = 4 * j + g4;
          const f32x4 a0 = *(const ALAS f32x4*)(St + row * 128 + c16 * 8), a1 = *(const ALAS f32x4*)(St + row * 128 + c16 * 8 + 4);
          u32x4 w = {cvtpk(a0[0], a0[1]), cvtpk(a0[2], a0[3]), cvtpk(a1[0], a1[1]), cvtpk(a1[2], a1[3])};
          *(u32x4*)(Ow + (size_t)row * U.opitch) = w; } }
    if (hi == 0) { U.den[(size_t)(qlo + r32) * U.spitch] = l_reg; U.mx[(size_t)(qlo + r32) * U.spitch] = m_reg; }
}
}

#define GAS __attribute__((address_space(1)))
#define LAS __attribute__((address_space(3)))
#define XB_TMO      128
#define XB_XCNT(j)  (256  + 64 * (j))
#define XB_XSUB(j)  (1280 + 64 * (j))
#define XB_XGEN(j)  (2304 + 64 * (j))
#define XB_TOP      3328
#define XB_TOPGEN   3392
#define XCD_BAR_WORDS 3456
#define XB_SPIN_CAP (1u << 18)

__device__ __forceinline__ unsigned xb_ld(unsigned* p)              { return __hip_atomic_load(p, __ATOMIC_RELAXED, __HIP_MEMORY_SCOPE_AGENT); }
__device__ __forceinline__ unsigned xb_add(unsigned* p, unsigned v) { return __hip_atomic_fetch_add(p, v, __ATOMIC_RELAXED, __HIP_MEMORY_SCOPE_AGENT); }
__device__ __forceinline__ unsigned xb_xcc_id() { return (unsigned)__builtin_amdgcn_s_getreg((3 << 11) | 20) & 0xFu; }
#define XB_SPIN(cond, bar) do { unsigned _sp = 0; while (cond) { __builtin_amdgcn_s_sleep(1); \
    if ((++_sp & 255u) == 0u) { if (xb_ld(&(bar)[XB_TMO])) break; if (_sp > XB_SPIN_CAP) { atomicAdd(&(bar)[XB_TMO], 1u); break; } } } } while (0)

struct XcdBarrier {
    unsigned* bar; unsigned x;
    volatile LAS unsigned* st;
};

__device__ __forceinline__ XcdBarrier xcd_barrier_post(unsigned* bar, volatile LAS unsigned* st) {
    XcdBarrier b; b.bar = bar; b.x = xb_xcc_id(); b.st = st;
    if (threadIdx.x == 0) (void)xb_add(&bar[XB_XCNT(b.x)], 1u);
    return b;
}
__device__ __forceinline__ void xcd_barrier_complete(unsigned* bar, unsigned x, unsigned& nloc, unsigned& nx) {
    const unsigned G = gridDim.x * gridDim.y * gridDim.z;
    unsigned sum, cnt, mine, sp = 0u;
    for (;;) {
        sum = 0u; cnt = 0u; mine = 0u;
#pragma unroll
        for (unsigned j = 0; j < 16; ++j) { const unsigned c = xb_ld(&bar[XB_XCNT(j)]); sum += c; cnt += (c > 0u) ? 1u : 0u; mine = (j == x) ? c : mine; }
        if (sum == G) break;
        __builtin_amdgcn_s_sleep(1);
        if ((++sp & 255u) == 0u) { if (xb_ld(&bar[XB_TMO])) break; if (sp > XB_SPIN_CAP) { atomicAdd(&bar[XB_TMO], 1u); break; } }
    }
    nloc = mine > 0u ? mine : 1u; nx = cnt > 0u ? cnt : 1u;
}

__device__ __forceinline__ void xcd_barrier(const XcdBarrier& b) {
    asm volatile("s_waitcnt vmcnt(0)" ::: "memory");
    __syncthreads();
    if (threadIdx.x == 0) {
        unsigned* bar = b.bar;
        __builtin_amdgcn_s_waitcnt(0);
        unsigned nloc = b.st[0], nx = b.st[1];
        if (nloc == 0u) { xcd_barrier_complete(bar, b.x, nloc, nx); b.st[0] = nloc; b.st[1] = nx; }
        const unsigned old = xb_add(&bar[XB_XSUB(b.x)], 1u);
        const unsigned gen = old / nloc;
        if (old + 1u == (gen + 1u) * nloc) {
            __builtin_amdgcn_fence(__ATOMIC_RELEASE, "agent");
            asm volatile("s_waitcnt vmcnt(0)" ::: "memory");
            const unsigned og = xb_add(&bar[XB_TOP], 1u);
            const unsigned tg = og / nx;
            if (og + 1u == (tg + 1u) * nx) xb_add(&bar[XB_TOPGEN], 1u);
            else XB_SPIN(xb_ld(&bar[XB_TOPGEN]) == tg, bar);
            __builtin_amdgcn_fence(__ATOMIC_ACQUIRE, "agent");
            xb_add(&bar[XB_XGEN(b.x)], 1u);
            asm volatile("s_waitcnt vmcnt(0)" ::: "memory");
        } else {
            XB_SPIN(xb_ld(&bar[XB_XGEN(b.x)]) == gen, bar);
            __builtin_amdgcn_fence(__ATOMIC_ACQUIRE, "agent");
            asm volatile("s_waitcnt vmcnt(0)" ::: "memory");
        }
    }
    __syncthreads();
}


constexpr int BATCH = 2, SEQ = 4096, DM = 2048, MROWS = BATCH * SEQ, DFF = 5504, HD = 128, HA = 8, HB = 8, DPROJ = 6152, NQKV = 6144;
constexpr float RMS_EPS = 1e-6f;
constexpr int NWAVES = 8, NTHREADS = 512;
constexpr int LDS_BYTES = 151552;
constexpr int RING_BYTES = 131072, XCH_OFF = RING_BYTES, MISC_OFF = XCH_OFF + 8192, RS_OFF = MISC_OFF + 128, GN_OFF = RS_OFF + 6 * 256 * 4;
static_assert(GN_OFF + 512 * 4 <= LDS_BYTES, "LDS map");
typedef unsigned short bf16;
typedef float f32x4 __attribute__((ext_vector_type(4)));
typedef unsigned u32x4v __attribute__((ext_vector_type(4)));
typedef unsigned u32x2v __attribute__((ext_vector_type(2)));
typedef float f32x2v __attribute__((ext_vector_type(2)));

constexpr size_t MiB = 1u << 20;
constexpr size_t WS_CTL = 0; constexpr int CW_BAR = 4096; constexpr size_t CTL_ZERO_BYTES = 64 * 1024;
constexpr size_t WS_WF = 64 * 1024;
constexpr size_t WS_LOGF = 128 * 1024;
constexpr size_t WS_PSS = 384 * 1024;
constexpr size_t WS_STAT = 640 * 1024;
constexpr size_t WS_TBL = 3712 * 1024;
constexpr size_t WS_FSTAT = 2304 * 1024;
constexpr size_t WS_W1I = 4 * MiB;
constexpr size_t WS_W1O = WS_W1I + 43 * MiB;
constexpr size_t WS_WIN = WS_W1O + 22 * MiB;
constexpr size_t WS_WOUT = WS_WIN + 24 * MiB;
constexpr size_t WS_W2I = WS_WOUT + 8 * MiB;
constexpr size_t WS_W2O = WS_W2I + 43 * MiB;
constexpr size_t WS_H = WS_W2O + 22 * MiB;
constexpr size_t WS_ACT = WS_H + 32 * MiB;
constexpr size_t WS_OPART = WS_ACT + 96 * MiB;
constexpr size_t WS_END = WS_OPART + 48 * MiB;

struct Args {
    const float* x; const float* n1; const float* w1i; const float* w1o; const float* nmix; const float* win;
    const float* gains[4]; const float* fbias; const float* rel; const float* wout; const float* n2; const float* w2i; const float* w2o;
    float* out; unsigned char* ws; int ph_lo, ph_hi;
};

__device__ __forceinline__ float wave_sum(float v) {
#pragma unroll
    for (int o = 1; o < 64; o <<= 1) v += __shfl_xor(v, o);
    return v;
}
__device__ __forceinline__ unsigned f2bf(float f) { unsigned u = __builtin_bit_cast(unsigned, f); return (u + 0x7fffu + ((u >> 16) & 1u)) >> 16; }
__device__ __forceinline__ unsigned pk2(float lo, float hi) { return f2bf(lo) | (f2bf(hi) << 16); }

struct ConvTab { const float* src[6]; bf16* dst[6]; };
constexpr int CV_I0 = (DM / 64) * (2 * DFF / 64), CV_I1 = (DFF / 64) * (DM / 64), CV_I2 = (DM / 64) * (NQKV / 64), CV_I3 = (DM / 64) * (DM / 64);
constexpr int CV_E0 = CV_I0, CV_E1 = CV_E0 + CV_I1, CV_E2 = CV_E1 + CV_I2, CV_E3 = CV_E2 + CV_I3, CV_E4 = CV_E3 + CV_I0, CV_E5 = CV_E4 + CV_I1;
__device__ __forceinline__ void conv_decode(int it, const float* w1i, const float* w1o, const float* win, const float* wout, const float* w2i, const float* w2o,
                                            bf16* W1I, bf16* W1O, bf16* WIN, bf16* WOUT, bf16* W2I, bf16* W2O, const float* g1, const float* gmix, const float* g2, const float*& src, bf16*& dst, int& ldw, int& K, const float*& gk) {
    int r = it; const float* W; bf16* WT; int nblk, kind; const float* gv = nullptr;
    if (r < CV_E0) { W = w1i; WT = W1I; K = DM; ldw = 2 * DFF; nblk = 2 * DFF / 64; kind = 1; gv = g1; }
    else if (r < CV_E1) { r -= CV_E0; W = w1o; WT = W1O; K = DFF; ldw = DM; nblk = DM / 64; kind = 0; }
    else if (r < CV_E2) { r -= CV_E1; W = win; WT = WIN; K = DM; ldw = DPROJ; nblk = NQKV / 64; kind = 0; gv = gmix; }
    else if (r < CV_E3) { r -= CV_E2; W = wout; WT = WOUT; K = DM; ldw = DM; nblk = DM / 64; kind = 0; }
    else if (r < CV_E4) { r -= CV_E3; W = w2i; WT = W2I; K = DM; ldw = 2 * DFF; nblk = 2 * DFF / 64; kind = 1; gv = g2; }
    else { r -= CV_E4; W = w2o; WT = W2O; K = DFF; ldw = DM; nblk = DM / 64; kind = 0; }
    const int kb = r / nblk, nb = r - kb * nblk, n0 = nb * 64;
    int drow = n0;
    if (kind == 1) { const int half = n0 / DFF, jj = n0 - half * DFF; drow = (jj >> 7) * 256 + half * 128 + (jj & 127); }
    src = W + (size_t)(kb * 64) * ldw + n0; dst = WT + (size_t)drow * K + kb * 64; gk = gv ? gv + kb * 64 : nullptr;
}
__device__ __forceinline__ unsigned cvtpk_bf16(float lo, float hi) { unsigned r; asm volatile("v_cvt_pk_bf16_f32 %0, %1, %2" : "=v"(r) : "v"(lo), "v"(hi)); return r; }
#define FILL_RS(S_) do { LAS float* rs_ = (LAS float*)(ldsl + RS_OFF); pg8::Unit u_; int pm_[6]; int nu_ = 0;                               \
        _Pragma("unroll") for (int i_ = 0; i_ < 6; ++i_) { pm_[i_] = 0; if ((S_).next(i_, u_)) { pm_[i_] = u_.pm; nu_ = i_ + 1; } }          \
        _Pragma("unroll") for (int r_ = 0; r_ < 3; ++r_) { const int idx_ = tid + r_ * NTHREADS, ui_ = idx_ >> 8;                           \
            if (ui_ < nu_) { const int pmv_ = (ui_ == 0) ? pm_[0] : (ui_ == 1) ? pm_[1] : (ui_ == 2) ? pm_[2] : (ui_ == 3) ? pm_[3] : (ui_ == 4) ? pm_[4] : pm_[5]; \
                const float* pp_ = PSS + (size_t)(pmv_ * 256 + (idx_ & 255)) * 8;                                                         \
                const f32x4 p0_ = *(const f32x4*)pp_, p1_ = *(const f32x4*)(pp_ + 4);                                                    \
                rs_[idx_] = 1.0f / sqrtf((((p0_[0] + p0_[1]) + (p0_[2] + p0_[3])) + ((p1_[0] + p1_[1]) + (p1_[2] + p1_[3]))) * (1.0f / DM) + RMS_EPS); } } \
        __syncthreads(); } while (0)
#define CONV_ARGS a.w1i, a.w1o, a.win, a.wout, a.w2i, a.w2o, W1I, W1O, WIN, WOUT, W2I, W2O, a.n1, a.nmix, a.n2
#define CONV_RANGE(lo_, hi_, w_, nw_, T_, NTST_) do {                                                                                           \
        const int l15_ = lane & 15, g_ = lane >> 4; int it_ = (lo_) + (w_);                                                            \
        f32x4 va_[8], vb_[8]; f32x2v ga_[8]; const float* src_; bf16* dst_; int ldw_, K_; const float* gk_;                              \
        if (it_ < (hi_)) { conv_decode(it_, CONV_ARGS, src_, dst_, ldw_, K_, gk_);                                                          \
            const float* p_ = src_ + (size_t)(2 * g_) * ldw_ + 4 * l15_;                                                               \
            _Pragma("unroll") for (int i = 0; i < 8; ++i) { va_[i] = __builtin_nontemporal_load((const f32x4*)(p_ + (size_t)(8 * i) * ldw_)); vb_[i] = __builtin_nontemporal_load((const f32x4*)(p_ + (size_t)(8 * i + 1) * ldw_)); }   \
            _Pragma("unroll") for (int i = 0; i < 8; ++i) ga_[i] = gk_ ? *(const f32x2v*)(gk_ + 8 * i + 2 * g_) : (f32x2v){1.f, 1.f}; }   \
        while (it_ < (hi_)) {                                                                                                           \
            _Pragma("unroll") for (int i = 0; i < 8; ++i) _Pragma("unroll") for (int j = 0; j < 4; ++j)                                 \
                (T_)[(4 * l15_ + j) * 32 + ((i ^ (l15_ & 7)) << 2) + g_] = cvtpk_bf16(va_[i][j] * ga_[i].x, vb_[i][j] * ga_[i].y);                             \
            bf16* dcur_ = dst_; const int Kcur_ = K_; it_ += (nw_);                                                                     \
            if (it_ < (hi_)) { conv_decode(it_, CONV_ARGS, src_, dst_, ldw_, K_, gk_);                                                      \
                const float* p_ = src_ + (size_t)(2 * g_) * ldw_ + 4 * l15_;                                                           \
                _Pragma("unroll") for (int i = 0; i < 8; ++i) { va_[i] = __builtin_nontemporal_load((const f32x4*)(p_ + (size_t)(8 * i) * ldw_)); vb_[i] = __builtin_nontemporal_load((const f32x4*)(p_ + (size_t)(8 * i + 1) * ldw_)); }   \
            _Pragma("unroll") for (int i = 0; i < 8; ++i) ga_[i] = gk_ ? *(const f32x2v*)(gk_ + 8 * i + 2 * g_) : (f32x2v){1.f, 1.f}; }   \
            _Pragma("unroll") for (int s2 = 0; s2 < 8; ++s2) { const int n_ = 8 * s2 + (lane >> 3), c_ = lane & 7;                       \
                const u32x4v wv_ = *(const LAS u32x4v*)((T_) + n_ * 32 + ((c_ ^ ((n_ >> 2) & 7)) << 2));                                 \
                if (NTST_) __builtin_nontemporal_store(wv_, (u32x4v*)(dcur_ + (size_t)n_ * Kcur_ + 8 * c_)); else *(u32x4v*)(dcur_ + (size_t)n_ * Kcur_ + 8 * c_) = wv_; }                                                                \
        } } while (0)

#define CONV_LOAD2(S_, it_) do { conv_decode(it_, CONV_ARGS, src##S_, dst##S_, ldw##S_, K##S_, gk##S_);                                         \
            const float* p_ = src##S_ + (size_t)(2 * g_) * ldw##S_ + 4 * l15_;                                                              \
            _Pragma("unroll") for (int i = 0; i < 8; ++i) { va##S_[i] = __builtin_nontemporal_load((const f32x4*)(p_ + (size_t)(8 * i) * ldw##S_)); vb##S_[i] = __builtin_nontemporal_load((const f32x4*)(p_ + (size_t)(8 * i + 1) * ldw##S_)); }   \
            _Pragma("unroll") for (int i = 0; i < 8; ++i) ga##S_[i] = gk##S_ ? *(const f32x2v*)(gk##S_ + 8 * i + 2 * g_) : (f32x2v){1.f, 1.f}; } while (0)
#define CONV_EMIT2(S_, T_, NTST_) do {                                                                                                          \
            _Pragma("unroll") for (int i = 0; i < 8; ++i) _Pragma("unroll") for (int j = 0; j < 4; ++j)                                 \
                (T_)[(4 * l15_ + j) * 32 + ((i ^ (l15_ & 7)) << 2) + g_] = cvtpk_bf16(va##S_[i][j] * ga##S_[i].x, vb##S_[i][j] * ga##S_[i].y);       \
            _Pragma("unroll") for (int s2 = 0; s2 < 8; ++s2) { const int n_ = 8 * s2 + (lane >> 3), c_ = lane & 7;                       \
                const u32x4v wv_ = *(const LAS u32x4v*)((T_) + n_ * 32 + ((c_ ^ ((n_ >> 2) & 7)) << 2));                                 \
                if (NTST_) __builtin_nontemporal_store(wv_, (u32x4v*)(dst##S_ + (size_t)n_ * K##S_ + 8 * c_)); else *(u32x4v*)(dst##S_ + (size_t)n_ * K##S_ + 8 * c_) = wv_; } } while (0)
#define CONV_RANGE2(lo_, hi_, w_, nw_, T_, NTST_) do {                                                                                          \
        const int l15_ = lane & 15, g_ = lane >> 4; int itA_ = (lo_) + (w_), itB_ = itA_ + (nw_);                                      \
        f32x4 vaA[8], vbA[8], vaB[8], vbB[8]; f32x2v gaA[8], gaB[8]; const float* srcA; const float* srcB; bf16* dstA; bf16* dstB; int ldwA, ldwB, KA, KB; const float* gkA; const float* gkB;   \
        if (itA_ < (hi_)) CONV_LOAD2(A, itA_);                                                                                          \
        if (itB_ < (hi_)) CONV_LOAD2(B, itB_);                                                                                          \
        for (;;) {                                                                                                                      \
            if (!(itA_ < (hi_))) break;                                                                                                 \
            CONV_EMIT2(A, T_, NTST_);                                                                                                   \
            itA_ += 2 * (nw_); if (itA_ < (hi_)) CONV_LOAD2(A, itA_);                                                                   \
            if (!(itB_ < (hi_))) break;                                                                                                 \
            CONV_EMIT2(B, T_, NTST_);                                                                                                   \
            itB_ += 2 * (nw_); if (itB_ < (hi_)) CONV_LOAD2(B, itB_);                                                                   \
        } } while (0)
#ifndef TAIL_W2I
#define TAIL_W2I 0
#endif

__device__ __forceinline__ void norm_row(const float* xrow, const float* g, bf16* orow, int lane, const float* wf, const float* fbias, float* logf_row) {
    const f32x4* xr = (const f32x4*)xrow + lane; const f32x4* gr = (const f32x4*)g + lane;
    f32x4 v[8]; float s = 0.f;
#pragma unroll
    for (int j = 0; j < 8; ++j) { v[j] = __builtin_nontemporal_load(xr + 64 * j); s += (v[j].x * v[j].x + v[j].y * v[j].y) + (v[j].z * v[j].z + v[j].w * v[j].w); }
    const float rstd = 1.0f / sqrtf(wave_sum(s) * (1.0f / DM) + RMS_EPS);
    unsigned long long* o8 = (unsigned long long*)orow + lane;
#pragma unroll
    for (int j = 0; j < 8; ++j) { v[j] = g ? v[j] * rstd * gr[64 * j] : v[j] * rstd;
        o8[64 * j] = (unsigned long long)pk2(v[j].x, v[j].y) | ((unsigned long long)pk2(v[j].z, v[j].w) << 32); }
    if (wf != nullptr) {
        float my = 0.f;
#pragma unroll
        for (int c = 0; c < 8; ++c) { const f32x4* wr = (const f32x4*)(wf + c * DM) + lane; float a = 0.f;
#pragma unroll
            for (int j = 0; j < 8; ++j) { const f32x4 w = wr[64 * j]; a += (v[j].x * w.x + v[j].y * w.y) + (v[j].z * w.z + v[j].w * w.w); }
            a = wave_sum(a); if (lane == c) my = a; }
        if (lane < 8) { const float z = my + fbias[lane]; logf_row[lane] = fminf(z, 0.f) - log1pf(expf(-fabsf(z))); }
    }
}

__global__ void __launch_bounds__(NTHREADS, 2) hybrid_fwd(Args a) {
    extern __shared__ __attribute__((aligned(16))) unsigned char lds[];
    const int tid = threadIdx.x, lane = tid & 63, wave = __builtin_amdgcn_readfirstlane(tid >> 6);
    const int G = gridDim.x, bx = blockIdx.x;
    const int gw = bx * NWAVES + wave, NGW = G * NWAVES;
    unsigned char* ws = a.ws;
    bf16* W1I = (bf16*)(ws + WS_W1I); bf16* W1O = (bf16*)(ws + WS_W1O); bf16* WIN = (bf16*)(ws + WS_WIN); bf16* WOUT = (bf16*)(ws + WS_WOUT);
    bf16* W2I = (bf16*)(ws + WS_W2I); bf16* W2O = (bf16*)(ws + WS_W2O);
    bf16* H = (bf16*)(ws + WS_H); bf16* ACT = (bf16*)(ws + WS_ACT); bf16* OPART = (bf16*)(ws + WS_OPART);
    bf16* WFB = (bf16*)(ws + WS_WF); float* LOGF = (float*)(ws + WS_LOGF); float* PSS = (float*)(ws + WS_PSS);
    float* DEN = (float*)(ws + WS_STAT); float* MX = DEN + 3 * MROWS * 8;
    float* TBL = (float*)(ws + WS_TBL);
    bf16* X1B = (bf16*)a.out;
    bf16* X2B = (bf16*)(ws + WS_W1I);
    bf16* FPART = (bf16*)(ws + WS_W1I); float* FDEN = (float*)(ws + WS_FSTAT); float* FMX = FDEN + 640 * 256;
    unsigned* CTL = (unsigned*)(ws + WS_CTL);
    LAS unsigned char* ldsl = (LAS unsigned char*)lds;
    const int lo = a.ph_lo, hi = a.ph_hi;
#ifdef ONLY_PHASE
#define IN(k) ((k) == ONLY_PHASE)
#else
#define IN(k) (lo <= (k) && (k) < hi)
#endif
#if MK_MULTI
#define GRID_SYNC() do {} while (0)
#else
    for (int u = tid; u < 32; u += NTHREADS) ((LAS unsigned*)(ldsl + MISC_OFF))[u] = 0u;
    __syncthreads();
    XcdBarrier bar = xcd_barrier_post(CTL + CW_BAR, (volatile LAS unsigned*)(ldsl + MISC_OFF) + 8);
#define grid_sync_() xcd_barrier(bar)
#ifdef PROBE_K
    unsigned long long t_prev = __builtin_amdgcn_s_memrealtime(); int ph_ctr = 0;
#define GRID_SYNC() do { grid_sync_(); { const unsigned long long now_ = __builtin_amdgcn_s_memrealtime(); \
        if (ph_ctr == PROBE_K) { const unsigned long long tgt_ = now_ + (now_ - t_prev); while (__builtin_amdgcn_s_memrealtime() < tgt_) __builtin_amdgcn_s_sleep(8); } \
        t_prev = __builtin_amdgcn_s_memrealtime(); ++ph_ctr; } } while (0)
#else
#define GRID_SYNC() grid_sync_()
#endif
#endif

#ifdef REPEAT_P0
    for (int rep_ = 0; rep_ < 2; ++rep_)
#endif
    if (IN(0)) {
        if (bx == 1 % G) { const int k = tid >> 7, j = tid & 127; const float* gp = (k == 0) ? a.gains[0] : (k == 1) ? a.gains[1] : (k == 2) ? a.gains[2] : a.gains[3];
            ((float*)(CTL + 256))[tid] = gp[j]; }
        { LAS unsigned* Tw = (LAS unsigned*)(ldsl + wave * 8192);
          CONV_RANGE(0, CV_E0, gw, NGW, Tw, false);
          CONV_RANGE(CV_E3 + TAIL_W2I, CV_E4, gw, NGW, Tw, true); }
        if (bx >= 8 && bx < 32 && tid < att::TB_N) {
            const int ph = bx - 8, pat = ph >> 3, hd = ph & 7, dil = (pat == 0) ? 1 : (pat == 1) ? 4 : 16, delta = tid - att::TB_PAD; float v = 0.f;
            if (delta >= 0 && delta <= 128) {
                const int dist = delta * dil; int bucket;
                if (dist < 16) bucket = dist;
                else { const float dd = (float)dist; int lg = 16 + (int)(logf(dd / 16.0f) / 4.852030263919617f * 16.0f); bucket = lg < 31 ? lg : 31; }
                v = a.rel[bucket * 8 + hd] * att::INV_SCALE;
            }
            TBL[ph * att::TB_N + tid] = v;
        }
        for (int i = bx * NTHREADS + tid; i < 16 * DM; i += G * NTHREADS) { const int c = i / DM, k = i % DM; WFB[i] = (c < 8) ? (bf16)f2bf(a.win[(size_t)k * DPROJ + NQKV + c] * a.nmix[k]) : (bf16)0; }
        for (int m = gw; m < MROWS; m += NGW) norm_row(a.x + (size_t)m * DM, nullptr, H + (size_t)m * DM, lane, nullptr, nullptr, nullptr);
        if (hi > 1) GRID_SYNC();
    }
    if (IN(1)) {
        pg8::Gemm g{H, W1I, MROWS, 2 * DFF, DM}; pg8::StaticOrder S; S.init(MROWS, 2 * DFF, G, bx);
        pg8::EpiSwiglu E{ACT, DFF, nullptr};
        pg8::gemm_phase<pg8::EpiSwiglu, pg8::StaticOrder, true, true>(ldsl, g, S, E);
        { const int rem = ((MROWS / 256) * (2 * DFF / 256)) % G;
          if (rem > 0 && bx >= rem) { LAS unsigned* Tw = (LAS unsigned*)(ldsl + wave * 8192); CONV_RANGE2(CV_E0, CV_E2, (bx - rem) * NWAVES + wave, (G - rem) * NWAVES, Tw, false);
                                      CONV_RANGE2(CV_E2, CV_E3 + TAIL_W2I, (bx - rem) * NWAVES + wave, (G - rem) * NWAVES, Tw, true); }
          else if (rem == 0) { LAS unsigned* Tw = (LAS unsigned*)(ldsl + wave * 8192); CONV_RANGE(CV_E0, CV_E2, gw, NGW, Tw, false); CONV_RANGE(CV_E2, CV_E3 + TAIL_W2I, gw, NGW, Tw, true); } }
        if (hi > 2) GRID_SYNC();
    }
    if (IN(2)) {
        pg8::Gemm g{ACT, W1O, MROWS, DM, DFF}; pg8::StaticOrder S; S.init(MROWS, DM, G, bx);
        pg8::EpiResNorm2<false> E{a.x, X1B, DM, 0.5f, PSS};
        pg8::gemm_phase<pg8::EpiResNorm2<false>, pg8::StaticOrder, false, true>(ldsl, g, S, E);
        if (hi > 4) GRID_SYNC();
    }
    if (IN(4)) {
        {
            typedef short bf16x8v __attribute__((ext_vector_type(8)));
            LAS float* red = (LAS float*)ldsl;
            for (int blk = bx; blk < MROWS / 32; blk += G) {
                const int rowbase = blk * 32;
                const bf16* ap = X1B + (size_t)(rowbase + (lane & 15)) * DM + wave * 256 + 8 * (lane >> 4);
                const bf16* bp = WFB + (size_t)(lane & 15) * DM + wave * 256 + 8 * (lane >> 4);
                bf16x8v av0[8], av1[8], bv[8];
#pragma unroll
                for (int ks = 0; ks < 8; ++ks) { av0[ks] = *(const bf16x8v*)(ap + 32 * ks); av1[ks] = *(const bf16x8v*)(ap + (size_t)16 * DM + 32 * ks); bv[ks] = *(const bf16x8v*)(bp + 32 * ks); }
                f32x4 acc0 = {0.f, 0.f, 0.f, 0.f}, acc1 = {0.f, 0.f, 0.f, 0.f};
#pragma unroll
                for (int ks = 0; ks < 8; ++ks) { acc0 = __builtin_amdgcn_mfma_f32_16x16x32_bf16(av0[ks], bv[ks], acc0, 0, 0, 0); acc1 = __builtin_amdgcn_mfma_f32_16x16x32_bf16(av1[ks], bv[ks], acc1, 0, 0, 0); }
                *(LAS f32x4*)(red + ((wave * 2 + 0) * 64 + lane) * 4) = acc0; *(LAS f32x4*)(red + ((wave * 2 + 1) * 64 + lane) * 4) = acc1;
                __syncthreads();
                if (wave < 2) {
                    f32x4 accf = {0.f, 0.f, 0.f, 0.f};
#pragma unroll
                    for (int w = 0; w < 8; ++w) accf += *(const LAS f32x4*)(red + ((w * 2 + wave) * 64 + lane) * 4);
                    const int c = lane & 15, r4 = rowbase + wave * 16 + 4 * (lane >> 4);
                    if (c < 8) {
                        const float fb = a.fbias[c]; f32x4 o;
#pragma unroll
                        for (int j = 0; j < 4; ++j) {
                            const f32x4 p0 = *(const f32x4*)(PSS + (size_t)(r4 + j) * 8), p1 = *(const f32x4*)(PSS + (size_t)(r4 + j) * 8 + 4);
                            const float rstd = 1.0f / sqrtf((((p0[0] + p0[1]) + (p0[2] + p0[3])) + ((p1[0] + p1[1]) + (p1[2] + p1[3]))) * (1.0f / DM) + RMS_EPS);
                            const float z = accf[j] * rstd + fb;
                            o[j] = fminf(z, 0.f) - log1pf(expf(-fabsf(z)));
                        }
                        const int b = r4 / SEQ, t = r4 % SEQ;
                        *(f32x4*)(LOGF + ((size_t)(b * 8 + c)) * SEQ + t) = o;
                    }
                }
                __syncthreads();
            }
        }
        pg8::Gemm g{X1B, WIN, MROWS, NQKV, DM}; pg8::StaticOrder S; S.init(MROWS, NQKV, G, bx);
        FILL_RS(S);
        { LAS float* gl = (LAS float*)(ldsl + GN_OFF); gl[tid] = ((const float*)(CTL + 256))[tid]; __syncthreads(); }
        pg8::EpiQKV E{ACT, NQKV, (const LAS float*)(ldsl + GN_OFF), (const LAS float*)(ldsl + RS_OFF), (LAS float*)(ldsl + XCH_OFF)};
#ifdef PROBE_EPI
        if (tid == 0) *(volatile LAS unsigned*)(ldsl + MISC_OFF + 64) = 0u;
        __syncthreads();
#endif
        pg8::gemm_phase<pg8::EpiQKV, pg8::StaticOrder, true, true>(ldsl, g, S, E);
#ifdef PROBE_EPI
        __syncthreads();
        { const unsigned tot_ = *(volatile LAS unsigned*)(ldsl + MISC_OFF + 64) / 512u;
          const unsigned long long t0_ = __builtin_amdgcn_s_memrealtime(); while (__builtin_amdgcn_s_memrealtime() - t0_ < tot_) __builtin_amdgcn_s_sleep(8); }
#endif
        if (hi > 5) GRID_SYNC();
    }
#ifdef REPEAT_P5
    for (int rep5_ = 0; rep5_ < 2; ++rep5_)
#else
    constexpr int rep5_ = 0;
#endif
    if (IN(5)) {
        LAS unsigned* misc = (LAS unsigned*)(ldsl + MISC_OFF);
        const bf16* QKV = ACT; constexpr int NFOX = 384;
        float skip_thr;
        { const float* gt = (const float*)(CTL + 256);
          float gq = fmaxf(fabsf(gt[256 + lane]), fabsf(gt[256 + 64 + lane])), gk = fmaxf(fabsf(gt[384 + lane]), fabsf(gt[384 + 64 + lane]));
#pragma unroll
          for (int o = 1; o < 64; o <<= 1) { gq = fmaxf(gq, __shfl_xor(gq, o)); gk = fmaxf(gk, __shfl_xor(gk, o)); }
          const float smax = 128.0f * att::SCALE * gq * gk * 1.0001f;
          skip_thr = __uint_as_float(__builtin_amdgcn_readfirstlane(__float_as_uint(-(110.0f + 2.0f * smax) * att::INV_SCALE))); }
#ifdef PROBE_ATT
        if (tid == 0) *(volatile LAS unsigned*)(ldsl + MISC_OFF + 68) = 0u;
        const unsigned long long tp0_ = __builtin_amdgcn_s_memrealtime();
#endif
#ifdef PROBE_CAT
        unsigned long long cat_acc_ = 0;
#endif
#ifdef PROBE_DIL
        if (tid == 0) *(volatile LAS unsigned*)(ldsl + MISC_OFF + 72) = 0u;
#endif
        if (tid == 0) misc[0] = atomicAdd(CTL + rep5_, 1u);
        __syncthreads();
        unsigned nxt_id = 0u;
        for (int kq = 0;; ++kq) {
            const int ui = __builtin_amdgcn_readfirstlane((int)misc[kq & 1]);
            if (ui >= NFOX + 768) break;
            att::UnitD U;
            if (ui < NFOX) {
                const int bh = ui & 15, v = ui >> 4, b = bh >> 3, h = bh & 7; int qb, part;
                if (v < 16) { qb = 15 - (v >> 1); part = v & 1; } else { qb = 23 - v; part = -1; }
                const bf16* base = QKV + (size_t)b * SEQ * NQKV;
                U.Q = base + 3072 + h * HD; U.K = base + 4096 + h * HD; U.V = base + 5120 + h * HD; U.pitch = NQKV;
                U.lf = LOGF + (size_t)bh * SEQ; U.rel = nullptr; U.head = h; U.dil = 1;
                U.q0 = qb * 256; U.W = 0x7fffffff; U.skip_thr = skip_thr;
                if (part < 0) { U.O = H + (size_t)b * SEQ * DM + 1024 + h * HD; U.opitch = DM; U.den = nullptr; U.mx = nullptr; U.spitch = 0; U.jlo = 0; U.jhi = qb * 4 + 4; }
                else { const int slot = bh * 16 + (qb - 8) * 2 + part;
                    U.O = FPART + (size_t)slot * 256 * HD - (size_t)qb * 256 * HD; U.opitch = HD;
                    U.den = FDEN + slot * 256 - qb * 256; U.mx = FMX + slot * 256 - qb * 256; U.spitch = 1;
                    U.jlo = part * 32; U.jhi = part ? qb * 4 + 4 : 32; }
            } else {
                const int r = ui - NFOX, u16 = r & 15, pbh = r >> 4, bh = pbh & 15, p = pbh >> 4, b = bh >> 3, h = bh & 7;
                const int dil = (p == 0) ? 1 : (p == 1) ? 4 : 16;
                int z, n;
                if (p == 0) { z = 0; n = u16; } else if (p == 1) { z = u16 >> 2; n = u16 & 3; } else { z = u16; n = 0; }
                const bf16* base = QKV + ((size_t)b * SEQ + z) * NQKV;
                U.Q = base + h * HD; U.K = base + 1024 + h * HD; U.V = base + 2048 + h * HD; U.pitch = dil * NQKV;
                U.O = OPART + (size_t)p * MROWS * 1024 + ((size_t)b * SEQ + z) * 1024 + h * HD; U.opitch = dil * 1024;
                U.den = DEN + (size_t)p * MROWS * 8 + ((size_t)b * SEQ + z) * 8 + h; U.mx = MX + (size_t)p * MROWS * 8 + ((size_t)b * SEQ + z) * 8 + h; U.spitch = dil * 8;
                U.lf = nullptr; U.rel = TBL + (p * 8 + h) * att::TB_N; U.head = h; U.dil = dil;
                U.q0 = n * 256; U.jlo = (n == 0) ? 0 : n * 4 - 2; U.jhi = n * 4 + 4; U.W = 129; U.skip_thr = 0.f;
            }
#ifdef PROBE_CAT
            const unsigned long long tu0_ = __builtin_amdgcn_s_memrealtime();
#endif
            if (ui < NFOX) att::attn_unit<true>(U, (ALAS char*)ldsl, CTL + rep5_, nxt_id); else att::attn_unit_dil(U, (ALAS char*)ldsl, CTL + rep5_, nxt_id);
#ifdef PROBE_CAT
            if ((ui < NFOX) == (PROBE_CAT == 0)) cat_acc_ += __builtin_amdgcn_s_memrealtime() - tu0_;
#endif
            if (tid == 0) misc[(kq + 1) & 1] = nxt_id;
            __syncthreads();
        }
#ifdef PROBE_CAT
        { const unsigned long long t0_ = __builtin_amdgcn_s_memrealtime(); while (__builtin_amdgcn_s_memrealtime() - t0_ < cat_acc_) __builtin_amdgcn_s_sleep(8); }
#endif
#ifdef PROBE_DIL
        { __syncthreads(); const unsigned acc_ = *(volatile LAS unsigned*)(ldsl + MISC_OFF + 72); const unsigned long long t0_ = __builtin_amdgcn_s_memrealtime(); while (__builtin_amdgcn_s_memrealtime() - t0_ < acc_) __builtin_amdgcn_s_sleep(8); }
#endif
#ifdef PROBE_ATT
        {
            __syncthreads();
            const unsigned long long tot_ = __builtin_amdgcn_s_memrealtime() - tp0_; const unsigned loop_ = *(volatile LAS unsigned*)(ldsl + MISC_OFF + 68);
            const unsigned long long ovh_ = tot_ > loop_ ? tot_ - loop_ : 0ull, t0_ = __builtin_amdgcn_s_memrealtime();
            while (__builtin_amdgcn_s_memrealtime() - t0_ < ovh_) __builtin_amdgcn_s_sleep(8); }
#endif
        if (hi > 6) GRID_SYNC();
    }
    if (IN(6)) {
#define P6_LOAD(X, gi_) const size_t pair##X = (gi_) >> 4; const int part##X = (int)((gi_) & 15); const size_t token##X = pair##X >> 4; const int hh##X = (int)(pair##X & 15);   \
            const bool fox##X = hh##X >= 8; const int b##X = (int)(token##X / SEQ), t##X = (int)(token##X % SEQ), qb##X = t##X >> 8, r##X = t##X & 255;                          \
            const bool live##X = !fox##X || qb##X >= 8; const int slot##X = (b##X * 8 + (hh##X & 7)) * 16 + ((qb##X - 8) & 7) * 2;                                            \
            const size_t sd##X = token##X * 8 + (hh##X & 7);                                                                                                                \
            const float* mp0##X = fox##X ? FMX + (size_t)slot##X * 256 + r##X : MX + sd##X; const float* mp1##X = fox##X ? mp0##X + 256 : mp0##X + (size_t)MROWS * 8;           \
            const float* lp0##X = fox##X ? FDEN + (size_t)slot##X * 256 + r##X : DEN + sd##X; const float* lp1##X = fox##X ? lp0##X + 256 : lp0##X + (size_t)MROWS * 8;         \
            const bf16* op0##X = fox##X ? FPART + ((size_t)slot##X * 256 + r##X) * HD + part##X * 8 : OPART + token##X * 1024 + (hh##X & 7) * HD + part##X * 8;                  \
            const bf16* op1##X = fox##X ? op0##X + (size_t)256 * HD : op0##X + (size_t)MROWS * 1024; const bf16* op2##X = fox##X ? op0##X : op0##X + (size_t)2 * MROWS * 1024;    \
            const float m0##X = *mp0##X, m1##X = *mp1##X, m2##X = fox##X ? -1e30f : mp0##X[(size_t)2 * MROWS * 8];                                                             \
            const float l0##X = *lp0##X, l1##X = *lp1##X, l2##X = fox##X ? 0.f : lp0##X[(size_t)2 * MROWS * 8];                                                                \
            const u32x4v q0##X = __builtin_nontemporal_load((const u32x4v*)op0##X), q1##X = __builtin_nontemporal_load((const u32x4v*)op1##X), q2##X = __builtin_nontemporal_load((const u32x4v*)op2##X);
#define P6_ACC(acc_, w_, q_) do { const unsigned qq_[4] = {q_.x, q_.y, q_.z, q_.w};                                                                                          \
            _Pragma("unroll") for (int j = 0; j < 4; ++j) { acc_[2 * j] += (w_) * __uint_as_float(qq_[j] << 16); acc_[2 * j + 1] += (w_) * __uint_as_float(qq_[j] & 0xffff0000u); } } while (0)
#define P6_FIN(X) do { const float mm_ = fmaxf(m0##X, fmaxf(m1##X, m2##X));                                                                                                   \
            const float w0_ = l0##X * __builtin_amdgcn_exp2f((m0##X - mm_) * att::C2), w1_ = l1##X * __builtin_amdgcn_exp2f((m1##X - mm_) * att::C2), w2_ = l2##X * __builtin_amdgcn_exp2f((m2##X - mm_) * att::C2); \
            float acc_[8] = {0.f, 0.f, 0.f, 0.f, 0.f, 0.f, 0.f, 0.f}; P6_ACC(acc_, w0_, q0##X); P6_ACC(acc_, w1_, q1##X); P6_ACC(acc_, w2_, q2##X);                              \
            const float inv_ = 1.0f / (w0_ + w1_ + w2_);                                                                                                                     \
            u32x4v o_; o_.x = pk2(acc_[0] * inv_, acc_[1] * inv_); o_.y = pk2(acc_[2] * inv_, acc_[3] * inv_); o_.z = pk2(acc_[4] * inv_, acc_[5] * inv_); o_.w = pk2(acc_[6] * inv_, acc_[7] * inv_); \
            if (live##X) *(u32x4v*)(H + token##X * DM + hh##X * HD + part##X * 8) = o_; } while (0)
        const size_t NIT = (size_t)MROWS * 16 * 16, stride = (size_t)G * NTHREADS;
        for (size_t gidx = (size_t)bx * NTHREADS + tid; gidx < NIT; gidx += 2 * stride) {
            const size_t g2 = gidx + stride < NIT ? gidx + stride : gidx;
            P6_LOAD(A, gidx) P6_LOAD(B, g2)
            P6_FIN(A); P6_FIN(B);
        }
#undef P6_LOAD
#undef P6_ACC
#undef P6_FIN
        if (hi > 7) GRID_SYNC();
#ifdef PROBE_BAR
        for (int i_ = 0; i_ < 8; ++i_) GRID_SYNC();
#endif
    }
    if (IN(7)) {
        pg8::Gemm g{H, WOUT, MROWS, DM, DM}; pg8::StaticOrder S; S.init(MROWS, DM, G, bx);
        pg8::EpiResNorm2<true> E{X1B, X2B, DM, 1.0f, PSS};
        pg8::gemm_phase<pg8::EpiResNorm2<true>, pg8::StaticOrder, false, true>(ldsl, g, S, E);
        if (hi > 9) GRID_SYNC();
    }
    if (IN(9)) {
        pg8::Gemm g{X2B, W2I, MROWS, 2 * DFF, DM}; pg8::StaticOrder S; S.init(MROWS, 2 * DFF, G, bx);
        FILL_RS(S);
        pg8::EpiSwiglu E{ACT, DFF, (const LAS float*)(ldsl + RS_OFF)};
        pg8::gemm_phase<pg8::EpiSwiglu, pg8::StaticOrder, true, true>(ldsl, g, S, E);
        { const int rem = ((MROWS / 256) * (2 * DFF / 256)) % G;
          if (rem > 0 && bx >= rem) { LAS unsigned* Tw = (LAS unsigned*)(ldsl + wave * 8192); CONV_RANGE(CV_E4, CV_E5, (bx - rem) * NWAVES + wave, (G - rem) * NWAVES, Tw, false); }
          else if (rem == 0) { LAS unsigned* Tw = (LAS unsigned*)(ldsl + wave * 8192); CONV_RANGE(CV_E4, CV_E5, gw, NGW, Tw, false); } }
        if (hi > 10) GRID_SYNC();
    }
    if (IN(10)) {
        pg8::Gemm g{ACT, W2O, MROWS, DM, DFF}; pg8::StaticOrder S; S.init(MROWS, DM, G, bx);
        pg8::EpiRes2 E{X2B, a.out, DM, 0.5f};
        pg8::gemm_phase<pg8::EpiRes2, pg8::StaticOrder, false, true>(ldsl, g, S, E);
    }
#ifdef PROBE_K
    GRID_SYNC();
#endif
#undef IN
}

extern "C" void kernel_launch(void* const* d_in, const int* in_sizes, int n_in, void* d_out, int out_size, void* d_ws, size_t ws_size, hipStream_t stream) {
    static int grid = 0;
    if (grid == 0) {
        int dev = 0, cus = 0, per_cu = 0;
        if (hipGetDevice(&dev) != hipSuccess || hipDeviceGetAttribute(&cus, hipDeviceAttributeMultiprocessorCount, dev) != hipSuccess) { fprintf(stderr, "kernel_launch: device query failed\n"); grid = -1; return; }
        if (hipFuncSetAttribute((const void*)hybrid_fwd, hipFuncAttributeMaxDynamicSharedMemorySize, LDS_BYTES) != hipSuccess) { fprintf(stderr, "kernel_launch: hipFuncSetAttribute failed\n"); grid = -1; return; }
        if (hipOccupancyMaxActiveBlocksPerMultiprocessor(&per_cu, (const void*)hybrid_fwd, NTHREADS, LDS_BYTES) != hipSuccess || per_cu < 1) fprintf(stderr, "kernel_launch: occupancy query says %d\n", per_cu);
        (void)hipGetLastError();
        if (ws_size < WS_END) { fprintf(stderr, "kernel_launch: workspace too small (%zu < %zu)\n", ws_size, (size_t)WS_END); grid = -1; return; }
        grid = cus;
    }
    if (grid < 0) return;
    Args a{};
    a.x = (const float*)d_in[0]; a.n1 = (const float*)d_in[1]; a.w1i = (const float*)d_in[2]; a.w1o = (const float*)d_in[3]; a.nmix = (const float*)d_in[4];
    a.win = (const float*)d_in[5]; a.gains[0] = (const float*)d_in[6]; a.gains[1] = (const float*)d_in[7]; a.gains[2] = (const float*)d_in[8]; a.gains[3] = (const float*)d_in[9];
    a.fbias = (const float*)d_in[10]; a.rel = (const float*)d_in[11]; a.wout = (const float*)d_in[12]; a.n2 = (const float*)d_in[13]; a.w2i = (const float*)d_in[14]; a.w2o = (const float*)d_in[15];
    a.out = (float*)d_out; a.ws = (unsigned char*)d_ws;
    if (hipMemsetAsync((char*)d_ws + WS_CTL, 0, CTL_ZERO_BYTES, stream) != hipSuccess) { fprintf(stderr, "kernel_launch: memset failed\n"); return; }
#if MK_MULTI
    for (int p = 0; p <= 10; ++p) { a.ph_lo = p; a.ph_hi = p + 1; hipLaunchKernelGGL(hybrid_fwd, dim3(grid), dim3(NTHREADS), LDS_BYTES, stream, a); }
#else
    a.ph_lo = 0; a.ph_hi = 11;
    hipLaunchKernelGGL(hybrid_fwd, dim3(grid), dim3(NTHREADS), LDS_BYTES, stream, a);
    const hipError_t e = hipPeekAtLastError();
    if (e != hipSuccess) fprintf(stderr, "kernel_launch: launch failed: %s (grid %d)\n", hipGetErrorString(e), grid);
#endif
}
```
